# Optimizing an MI355X kernel written in HIP

```python
import jax, jax.numpy as jnp
from jax import lax
import numpy as np

D_MODEL = 2048
BATCH = 2
SEQ = 4096
DEPTH = 1

HEAD_DIM = 128
ATTN_GROUPS = ((128, 1), (512, 4), (2048, 16))
N_GROUPS = len(ATTN_GROUPS)
HEADS_PER_GROUP = 4
N_ATTN_HEADS = N_GROUPS * HEADS_PER_GROUP
ATTN_WIDTH = N_ATTN_HEADS * HEAD_DIM
ATTN_OUT_WIDTH = HEADS_PER_GROUP * HEAD_DIM
ROPE_THETA = 10000.0
Q_BLOCK = 128
CONV_WIDTH = D_MODEL // 2
CONV_K = 3
IN_COLS = 3 * CONV_WIDTH + 3 * ATTN_WIDTH + 2 * D_MODEL
N_EXPERTS = 64
TOP_K = 8
N_EXPERT_GROUPS = 8
TOP_GROUPS = 4
D_EXPERT = D_MODEL // 4
ROUTED_SCALE = 2.5
EPS = 1e-6
NEG_INF = -1e30

kernel_name = "hybrid_conv_dilated_attn_moe_block"


def rmsnorm(x, g):
    xf = x.astype(jnp.float32)
    xf = xf * lax.rsqrt(jnp.mean(xf * xf, axis=-1, keepdims=True) + EPS)
    return (xf * g.astype(jnp.float32)).astype(x.dtype)


def rope_tables(positions):
    inv = ROPE_THETA ** (-jnp.arange(0, HEAD_DIM, 2, dtype=jnp.float32) / HEAD_DIM)
    ang = positions.astype(jnp.float32)[..., None] * inv
    return jnp.cos(ang)[:, :, None, :], jnp.sin(ang)[:, :, None, :]


def apply_rope(t, cos, sin):
    tf = t.astype(jnp.float32)
    t1, t2 = jnp.split(tf, 2, axis=-1)
    return jnp.concatenate([t1 * cos - t2 * sin, t2 * cos + t1 * sin], axis=-1).astype(t.dtype)


def dilated_window_attention(q, k, v, window, dilation):
    B, S, H, Dh = q.shape
    r = dilation
    band = window // r
    n_sub = S // r
    nb = -(-n_sub // Q_BLOCK)
    n_pad = nb * Q_BLOCK

    def to_sub(t):
        return t.reshape(B, n_sub, r, H, Dh).transpose(0, 3, 2, 1, 4)

    qs, ks, vs = to_sub(q), to_sub(k), to_sub(v)
    tail = n_pad - n_sub
    qs = jnp.pad(qs, ((0, 0), (0, 0), (0, 0), (0, tail), (0, 0)))
    kv_pad = ((0, 0), (0, 0), (0, 0), (Q_BLOCK, tail), (0, 0))
    ks_p, vs_p = jnp.pad(ks, kv_pad), jnp.pad(vs, kv_pad)

    def blocks(t):
        prev = t[..., :n_pad, :].reshape(B, H, r, nb, Q_BLOCK, Dh)
        cur = t[..., Q_BLOCK:, :].reshape(B, H, r, nb, Q_BLOCK, Dh)
        return jnp.concatenate([prev, cur], axis=-2)

    kb, vb = blocks(ks_p), blocks(vs_p)
    qb = qs.reshape(B, H, r, nb, Q_BLOCK, Dh)
    scores = jnp.einsum('bhrnqd,bhrnkd->bhrnqk', qb, kb,
                        preferred_element_type=jnp.float32)
    qi = jnp.arange(Q_BLOCK)[:, None]
    kj = jnp.arange(2 * Q_BLOCK)[None, :]
    dist = qi - kj + Q_BLOCK
    key_sub = jnp.arange(nb)[:, None, None] * Q_BLOCK + kj[None] - Q_BLOCK
    mask = (dist >= 0)[None] & (dist <= band)[None] & (key_sub >= 0)
    scores = jnp.where(mask, scores, NEG_INF)
    m = jnp.max(scores, axis=-1, keepdims=True)
    p = jnp.exp(scores - m)
    s = jnp.sum(p, axis=-1, keepdims=True)
    o = jnp.einsum('bhrnqk,bhrnkd->bhrnqd', p.astype(vb.dtype), vb,
                   preferred_element_type=jnp.float32) / s
    lse = (m + jnp.log(s))[..., 0]
    o = o.reshape(B, H, r, n_pad, Dh)[..., :n_sub, :].transpose(0, 3, 2, 1, 4).reshape(B, S, H, Dh)
    lse = lse.reshape(B, H, r, n_pad)[..., :n_sub].transpose(0, 3, 2, 1).reshape(B, S, H)
    return o, lse


def dilated_mixture_attention(q, k, v, positions):
    B, S = q.shape[:2]
    cos, sin = rope_tables(positions)
    q = apply_rope(q, cos, sin) * (HEAD_DIM ** -0.5)
    k = apply_rope(k, cos, sin)
    q = q.reshape(B, S, N_GROUPS, HEADS_PER_GROUP, HEAD_DIM)
    k = k.reshape(B, S, N_GROUPS, HEADS_PER_GROUP, HEAD_DIM)
    v = v.reshape(B, S, N_GROUPS, HEADS_PER_GROUP, HEAD_DIM)
    outs, lses = [], []
    for g, (window, dilation) in enumerate(ATTN_GROUPS):
        o_g, l_g = dilated_window_attention(q[:, :, g], k[:, :, g], v[:, :, g], window, dilation)
        outs.append(o_g)
        lses.append(l_g)
    wts = jax.nn.softmax(jnp.stack(lses, axis=0), axis=0)
    o = jnp.einsum('gbsh,gbshd->bshd', wts, jnp.stack(outs, axis=0))
    return o.reshape(B, S, ATTN_OUT_WIDTH).astype(v.dtype)


def short_gated_conv(b_gate, c_gate, v_in, conv_w):
    S = v_in.shape[1]
    u = c_gate * v_in
    up = jnp.pad(u, ((0, 0), (CONV_K - 1, 0), (0, 0)))
    conv = sum(conv_w[tap] * up[:, tap:tap + S] for tap in range(CONV_K))
    return b_gate * conv


def swiglu(t, wg, wu, wd):
    return (jax.nn.silu(t @ wg) * (t @ wu)) @ wd


def moe_ffn(h, w_router, router_bias, w_exp_gate, w_exp_up, w_exp_down, w_sh_gate, w_sh_up, w_sh_down):
    B, S, D = h.shape
    T = B * S
    t = h.reshape(T, D)
    scores = jax.nn.sigmoid(jnp.matmul(t, w_router, preferred_element_type=jnp.float32))
    sel = scores + router_bias.astype(jnp.float32)
    group_score = lax.top_k(sel.reshape(T, N_EXPERT_GROUPS, N_EXPERTS // N_EXPERT_GROUPS), 2)[0].sum(-1)
    _, top_g = lax.top_k(group_score, TOP_GROUPS)
    gmask = jax.nn.one_hot(top_g, N_EXPERT_GROUPS, dtype=jnp.float32).sum(1) > 0
    emask = jnp.repeat(gmask, N_EXPERTS // N_EXPERT_GROUPS, axis=1)
    _, top_e = lax.top_k(jnp.where(emask, sel, NEG_INF), TOP_K)
    w = jnp.take_along_axis(scores, top_e, axis=1)
    w = w / jnp.sum(w, axis=-1, keepdims=True) * ROUTED_SCALE
    gates = jnp.einsum('tk,tke->te', w, jax.nn.one_hot(top_e, N_EXPERTS, dtype=jnp.float32))

    def expert_step(acc, ex):
        wg, wu, wd, g = ex
        return acc + g[:, None].astype(t.dtype) * swiglu(t, wg, wu, wd), None

    routed, _ = lax.scan(expert_step, jnp.zeros_like(t),
                         (w_exp_gate, w_exp_up, w_exp_down, gates.T))
    shared = swiglu(t, w_sh_gate, w_sh_up, w_sh_down)
    return (routed + shared).reshape(B, S, D)


def setup_inputs(seed: int = 0) -> dict:
    key = jax.random.key(seed)
    ks = jax.random.split(key, 24)
    f32 = jnp.float32

    def nrm(k, shape, scale):
        return jax.random.normal(k, shape, f32) * scale

    L, D = DEPTH, D_MODEL
    return {
        "x": nrm(ks[0], (BATCH, SEQ, D), 1.0),
        "c": nrm(ks[1], (BATCH, D), 1.0),
        "positions": jnp.broadcast_to(jnp.arange(SEQ, dtype=jnp.int32), (BATCH, SEQ)),
        "norm_mix_g": 1.0 + nrm(ks[2], (L, D), 0.1),
        "w_ada": nrm(ks[3], (L, D, 6 * D), 0.5 * D ** -0.5),
        "b_ada": nrm(ks[4], (L, 6 * D), 0.01),
        "w_in": nrm(ks[5], (L, D, IN_COLS), D ** -0.5),
        "conv_w": nrm(ks[6], (L, CONV_K, CONV_WIDTH), CONV_K ** -0.5),
        "w_conv_out": nrm(ks[7], (L, CONV_WIDTH, D), CONV_WIDTH ** -0.5),
        "w_attn_out": nrm(ks[8], (L, ATTN_OUT_WIDTH, D), ATTN_OUT_WIDTH ** -0.5),
        "w_o": nrm(ks[9], (L, D, D), D ** -0.5),
        "norm_ffn_g": 1.0 + nrm(ks[10], (L, D), 0.1),
        "w_router": nrm(ks[11], (L, D, N_EXPERTS), D ** -0.5),
        "router_bias": nrm(ks[12], (L, N_EXPERTS), 0.01),
        "w_exp_gate": nrm(ks[13], (L, N_EXPERTS, D, D_EXPERT), D ** -0.5),
        "w_exp_up": nrm(ks[14], (L, N_EXPERTS, D, D_EXPERT), D ** -0.5),
        "w_exp_down": nrm(ks[15], (L, N_EXPERTS, D_EXPERT, D), D_EXPERT ** -0.5),
        "w_sh_gate": nrm(ks[16], (L, D, D_EXPERT), D ** -0.5),
        "w_sh_up": nrm(ks[17], (L, D, D_EXPERT), D ** -0.5),
        "w_sh_down": nrm(ks[18], (L, D_EXPERT, D), D_EXPERT ** -0.5),
        "norm_final_g": 1.0 + nrm(ks[19], (D,), 0.1),
    }


def reference(x, c, positions, norm_mix_g, w_ada, b_ada, w_in, conv_w, w_conv_out, w_attn_out,
              w_o, norm_ffn_g, w_router, router_bias, w_exp_gate, w_exp_up, w_exp_down,
              w_sh_gate, w_sh_up, w_sh_down, norm_final_g):
    B, S, D = x.shape
    split_at = [CONV_WIDTH, 2 * CONV_WIDTH, 3 * CONV_WIDTH,
                3 * CONV_WIDTH + ATTN_WIDTH, 3 * CONV_WIDTH + 2 * ATTN_WIDTH,
                3 * CONV_WIDTH + 3 * ATTN_WIDTH, 3 * CONV_WIDTH + 3 * ATTN_WIDTH + D]
    for l in range(DEPTH):
        mod = jax.nn.silu(c) @ w_ada[l] + b_ada[l]
        shift1, scale1, gate1, shift2, scale2, gate2 = [m[:, None, :] for m in jnp.split(mod, 6, axis=-1)]

        h = rmsnorm(x, norm_mix_g[l]) * (1.0 + scale1) + shift1
        proj = h @ w_in[l]
        b_c, c_c, v_c, q, k, v, g_conv, g_attn = jnp.split(proj, split_at, axis=-1)
        y_conv = short_gated_conv(b_c, c_c, v_c, conv_w[l]) @ w_conv_out[l]
        y_attn = dilated_mixture_attention(q.reshape(B, S, N_ATTN_HEADS, HEAD_DIM),
                                           k.reshape(B, S, N_ATTN_HEADS, HEAD_DIM),
                                           v.reshape(B, S, N_ATTN_HEADS, HEAD_DIM),
                                           positions) @ w_attn_out[l]
        merged = jax.nn.sigmoid(g_conv) * y_conv + jax.nn.sigmoid(g_attn) * y_attn
        x = x + gate1 * (merged @ w_o[l])

        h2 = rmsnorm(x, norm_ffn_g[l]) * (1.0 + scale2) + shift2
        x = x + gate2 * moe_ffn(h2, w_router[l], router_bias[l], w_exp_gate[l], w_exp_up[l],
                                w_exp_down[l], w_sh_gate[l], w_sh_up[l], w_sh_down[l])
    return rmsnorm(x, norm_final_g)
```

```cpp
#include <hip/hip_runtime.h>
#include <cstdio>
#include <cstdint>

#define GAS __attribute__((address_space(1)))
#define LAS __attribute__((address_space(3)))
typedef unsigned short bf16;
typedef short bf16x8 __attribute__((ext_vector_type(8)));
typedef float f32x4 __attribute__((ext_vector_type(4)));
typedef float f32x2 __attribute__((ext_vector_type(2)));
typedef unsigned u32x4 __attribute__((ext_vector_type(4)));
typedef unsigned u32x2 __attribute__((ext_vector_type(2)));

constexpr int NB = 2, SEQ = 4096, NT = NB * SEQ, D = 2048;
constexpr int CONVW = 1024, ATTW = 1536, HD = 128, AOW = 512;
constexpr int INC = 3 * CONVW + 3 * ATTW + 2 * D;
constexpr int COL_B = 0, COL_C = 1024, COL_V = 2048, COL_Q = 3072, COL_K = 4608, COL_VA = 6144, COL_GC = 7680, COL_GA = 9728;
constexpr int NE = 64, NEX = 65  , TOPK = 8, DE = 512;
constexpr float EPS = 1e-6f;
constexpr int NWAVES = 8, NTHREADS = 512;
constexpr int LISTCAP = 8192;

constexpr size_t MiB = 1u << 20;
constexpr size_t WS_CTL = 0, CTL_ZERO_BYTES = 1 * MiB;
constexpr size_t WS_MOD = 1 * MiB;
constexpr size_t WS_ROPE = 2 * MiB;
constexpr size_t WS_TKID = 6 * MiB;
constexpr size_t WS_TKW = WS_TKID + 256 * 1024;
constexpr size_t WS_TKPOS = WS_TKW + 256 * 1024;
constexpr size_t WS_LIST = 7 * MiB;
constexpr size_t WS_WC = 10 * MiB;
constexpr size_t WS_WA = 14 * MiB;
constexpr size_t WS_WO = 16 * MiB;
constexpr size_t WS_WIN = 24 * MiB;
constexpr size_t WS_WGU = 70 * MiB;
constexpr size_t WS_WD = 330 * MiB;
constexpr size_t WS_X1 = 460 * MiB;
constexpr size_t WS_PROJ = 524 * MiB;
constexpr size_t WS_H2 = 524 * MiB;
constexpr size_t WS_HS = 556 * MiB;
constexpr size_t WS_Y = 708 * MiB;
constexpr size_t WS_H = 708 * MiB;
constexpr size_t WS_CG = 766 * MiB;
constexpr size_t WS_AO = 782 * MiB;
constexpr size_t WS_T1 = 790 * MiB;
constexpr size_t WS_MG = 822 * MiB;
constexpr size_t WS_END = 998 * MiB;
constexpr int CW_CNT = 1024;

constexpr int LDS_BYTES = 147456;

__device__ __forceinline__ unsigned f2bf(float f) { unsigned u = __builtin_bit_cast(unsigned, f); return (u + 0x7fffu + ((u >> 16) & 1u)) >> 16; }
__device__ __forceinline__ unsigned pk2(float lo, float hi) { return f2bf(lo) | (f2bf(hi) << 16); }
__device__ __forceinline__ float bflo(unsigned w) { return __builtin_bit_cast(float, w << 16); }
__device__ __forceinline__ float bfhi(unsigned w) { return __builtin_bit_cast(float, w & 0xffff0000u); }
__device__ __forceinline__ float bf1(bf16 v) { return __builtin_bit_cast(float, ((unsigned)v) << 16); }
__device__ __forceinline__ float wave_sum(float v) {
#pragma unroll
    for (int o = 1; o < 64; o <<= 1) v += __shfl_xor(v, o);
    return v;
}
__device__ __forceinline__ float wave_max(float v) {
#pragma unroll
    for (int o = 1; o < 64; o <<= 1) v = fmaxf(v, __shfl_xor(v, o));
    return v;
}
__device__ __forceinline__ float sigmoidf_(float v) { return 1.0f / (1.0f + __expf(-v)); }
__host__ __device__ __forceinline__ int perm32(int rho) { const int n = rho >> 4, i = rho & 15; return 8 * (i >> 2) + 4 * n + (i & 3); }
#define LDS_WAIT() asm volatile("s_waitcnt lgkmcnt(0)" ::: "memory")

struct Frame {
    LAS unsigned char* lds;
    int tid, lane, wave, vcu, G;
    unsigned char* ws;
    const float *x, *c, *norm_mix_g, *w_ada, *b_ada, *w_in, *conv_w, *w_conv_out, *w_attn_out, *w_o, *norm_ffn_g, *w_router, *router_bias,
        *w_exp_gate, *w_exp_up, *w_exp_down, *w_sh_gate, *w_sh_up, *w_sh_down, *norm_final_g;
    const int* positions;
    float* out;
};

__device__ __forceinline__ void transpose_item(const float* W, int K, int N, bf16* WT, int k0, int n0, int row_off, bool ilv, int dd0, LAS float* scr, int lane) {
#pragma unroll 8
    for (int i = 0; i < 32; ++i) { const int kk = 2 * i + (lane >> 5); scr[kk * 33 + (lane & 31)] = W[(size_t)(k0 + kk) * N + n0 + (lane & 31)]; }
    LDS_WAIT(); asm volatile("" ::: "memory");
    const int c = lane & 7;
#pragma unroll
    for (int j = 0; j < 4; ++j) { const int n = (lane >> 3) + 8 * j; const LAS float* s = scr + (8 * c) * 33 + n;
        u32x4 o; o.x = pk2(s[0 * 33], s[1 * 33]); o.y = pk2(s[2 * 33], s[3 * 33]); o.z = pk2(s[4 * 33], s[5 * 33]); o.w = pk2(s[6 * 33], s[7 * 33]);
        const int dd = dd0 + n; const int drow = ilv ? (row_off + ((dd >> 2) << 3) + (dd & 3)) : (row_off + n);
        *(u32x4*)(WT + (size_t)drow * K + k0 + 8 * c) = o; }
    LDS_WAIT(); asm volatile("" ::: "memory");
}
__device__ __forceinline__ void transpose_mat_item(const float* W, int K, int N, bf16* WT, int item, int mode  , int row_off2, LAS float* scr, int lane) {
    const int nblk = N / 32, kb = item / nblk, nb = item % nblk, k0 = 64 * kb, n0 = 32 * nb;
    if (mode == 0) transpose_item(W, K, N, WT, k0, n0, n0, false, 0, scr, lane);
    else if (mode == 1) transpose_item(W, K, N, WT, k0, n0, row_off2, true, n0, scr, lane);
    else {
        if (n0 >= COL_Q && n0 < COL_VA) { const int hn = (n0 - COL_Q) & 127, hb = n0 - hn; transpose_item(W, K, N, WT, k0, n0, hb + ((hn >= 64) ? 4 : 0), true, hn & 63, scr, lane); }
        else transpose_item(W, K, N, WT, k0, n0, n0, false, 0, scr, lane);
    }
}

__device__ __forceinline__ void p0_prologue(Frame& F) {
    const int gw = F.vcu * NWAVES + F.wave, NGW = F.G * NWAVES;
    {
        LAS float* red = (LAS float*)(F.lds);
        for (int cc = F.vcu; cc < 256; cc += F.G) {
            const int g = F.lane / 12, cs = F.lane % 12;
            f32x4 a0 = {0.f, 0.f, 0.f, 0.f}, a1 = {0.f, 0.f, 0.f, 0.f};
            if (g < 5) {
                const int rbase = 256 * F.wave;
                for (int it = 0; it < 52; ++it) { const int rl = 5 * it + g; if (rl < 256) { const int r = rbase + rl;
                    const f32x4 w = *(const f32x4*)(F.w_ada + (size_t)r * (6 * D) + 48 * cc + 4 * cs);
                    const float c0 = F.c[r], c1 = F.c[D + r]; const float s0 = c0 * sigmoidf_(c0), s1 = c1 * sigmoidf_(c1);
                    a0 += w * s0; a1 += w * s1; } }
            }
            LAS float* my = red + (F.wave * 64 + F.lane) * 8;
            my[0] = a0.x; my[1] = a0.y; my[2] = a0.z; my[3] = a0.w; my[4] = a1.x; my[5] = a1.y; my[6] = a1.z; my[7] = a1.w;
            __syncthreads();
            if (F.tid < 96) { const int b = F.tid / 48, col = F.tid % 48, cs2 = col >> 2, comp = col & 3; float s = 0.f;
                for (int w = 0; w < 8; ++w) for (int gg = 0; gg < 5; ++gg) s += red[(w * 64 + gg * 12 + cs2) * 8 + b * 4 + comp];
                ((float*)(F.ws + WS_MOD))[b * 6 * D + 48 * cc + col] = s + F.b_ada[48 * cc + col]; }
            __syncthreads();
        }
    }
    {
        f32x2* tab = (f32x2*)(F.ws + WS_ROPE);
        for (int idx = (F.vcu * NTHREADS + F.tid); idx < NT * 64; idx += F.G * NTHREADS) { const int tok = idx >> 6, i = idx & 63;
            const float inv = exp2f(-(float)i * (13.287712379549449f / 64.0f));
            const double rev = (double)F.positions[tok] * (double)inv * 0.15915494309189535; const float fr = (float)(rev - floor(rev));
            tab[idx] = (f32x2){__builtin_amdgcn_cosf(fr), __builtin_amdgcn_sinf(fr)}; }
    }
    {
        LAS float* scr = (LAS float*)(F.lds + 16384 + F.wave * 16384);
        constexpr int I_IN = (D / 64) * (INC / 32), I_CO = (CONVW / 64) * (D / 32), I_AO = (AOW / 64) * (D / 32), I_WO = (D / 64) * (D / 32);
        constexpr int I_G1 = (D / 64) * (DE / 32)  , I_D1 = (DE / 64) * (D / 32)  ;
        constexpr int NITEMS = I_IN + I_CO + I_AO + I_WO + 65 * (2 * I_G1 + I_D1);
        bf16* wgu = (bf16*)(F.ws + WS_WGU); bf16* wd = (bf16*)(F.ws + WS_WD);
        for (int it = gw; it < NITEMS; it += NGW) {
            int r = it;
            if (r < I_IN) { transpose_mat_item(F.w_in, D, INC, (bf16*)(F.ws + WS_WIN), r, 2, 0, scr, F.lane); continue; } r -= I_IN;
            if (r < I_CO) { transpose_mat_item(F.w_conv_out, CONVW, D, (bf16*)(F.ws + WS_WC), r, 0, 0, scr, F.lane); continue; } r -= I_CO;
            if (r < I_AO) { transpose_mat_item(F.w_attn_out, AOW, D, (bf16*)(F.ws + WS_WA), r, 0, 0, scr, F.lane); continue; } r -= I_AO;
            if (r < I_WO) { transpose_mat_item(F.w_o, D, D, (bf16*)(F.ws + WS_WO), r, 0, 0, scr, F.lane); continue; } r -= I_WO;
            const int per_e = 2 * I_G1 + I_D1; const int e = r / per_e; int q = r % per_e;
            const float* sg = (e < NE) ? F.w_exp_gate + (size_t)e * D * DE : F.w_sh_gate;
            const float* su = (e < NE) ? F.w_exp_up + (size_t)e * D * DE : F.w_sh_up;
            const float* sd = (e < NE) ? F.w_exp_down + (size_t)e * DE * D : F.w_sh_down;
            if (q < I_G1) { transpose_mat_item(sg, D, DE, wgu + (size_t)e * 1024 * D, q, 1, 0, scr, F.lane); continue; } q -= I_G1;
            if (q < I_G1) { transpose_mat_item(su, D, DE, wgu + (size_t)e * 1024 * D, q, 1, 4, scr, F.lane); continue; } q -= I_G1;
            transpose_mat_item(sd, DE, D, wd + (size_t)e * D * DE, q, 0, 0, scr, F.lane);
        }
    }
}

__device__ __forceinline__ void p1_hnorm(Frame& F) {
    const int gw = F.vcu * NWAVES + F.wave, NGW = F.G * NWAVES;
    const float* mod = (const float*)(F.ws + WS_MOD); bf16* H = (bf16*)(F.ws + WS_H);
    for (int t = gw; t < NT; t += NGW) { const int b = t / SEQ;
        const f32x4* xr = (const f32x4*)(F.x + (size_t)t * D) + F.lane; f32x4 v[8]; float ss = 0.f;
#pragma unroll
        for (int j = 0; j < 8; ++j) { v[j] = xr[64 * j]; ss += (v[j].x * v[j].x + v[j].y * v[j].y) + (v[j].z * v[j].z + v[j].w * v[j].w); }
        const float rstd = rsqrtf(wave_sum(ss) * (1.f / D) + EPS);
        u32x2* o = (u32x2*)(H + (size_t)t * D) + F.lane;
#pragma unroll
        for (int j = 0; j < 8; ++j) { const int col = 4 * F.lane + 256 * j;
            const f32x4 g = *(const f32x4*)(F.norm_mix_g + col), sh = *(const f32x4*)(mod + b * 6 * D + col), sc = *(const f32x4*)(mod + b * 6 * D + D + col);
            const f32x4 y = v[j] * rstd * g * (sc + 1.0f) + sh;
            o[64 * j] = (u32x2){pk2(y.x, y.y), pk2(y.z, y.w)}; }
    }
}

struct Unit { int pm, pn, e, srow0, nvalid; };

struct SchedPlain {
    const bf16* A; const bf16* Bt; int K; int nM, nN, nwg, G, c;
    __device__ __forceinline__ void init(const bf16* A_, const bf16* Bt_, int M, int N, int K_, int G_, int c_) { A = A_; Bt = Bt_; K = K_; nM = M / 256; nN = N / 256; nwg = nM * nN; G = G_; c = c_; }
    __device__ __forceinline__ bool next(int i, Unit& u) const {
        const long L = (long)i * G + c; if (L >= nwg) return false;
        int wgid = (int)L; { const int q = nwg / 8, r = nwg % 8, xcd = wgid % 8, off = wgid / 8; wgid = (xcd < r ? xcd * (q + 1) : r * (q + 1) + (xcd - r) * q) + off; }
        const int nig = 8 * nN, gid = wgid / nig, fm = gid * 8, gsz = (nM - fm) < 8 ? (nM - fm) : 8;
        u.pm = fm + ((wgid % nig) % gsz); u.pn = (wgid % nig) / gsz; u.e = 0; u.srow0 = 256 * u.pm; u.nvalid = 256; return true;
    }
    __device__ __forceinline__ const bf16* a_row(const Unit& u, int rl) const { return A + (size_t)(256 * u.pm + rl) * K; }
    __device__ __forceinline__ const bf16* b_row(const Unit& u, int cl) const { return Bt + (size_t)(256 * u.pn + cl) * K; }
};
struct SchedMoE {
    const bf16* A; const bf16* Bt; const int* list; int K, NTN, G, c, nwg; size_t bstride; bool gather;
    const LAS int* tp; const LAS int* cnt; const LAS int* off;
    __device__ __forceinline__ bool next(int i, Unit& u) const {
        const long L = (long)i * G + c; if (L >= nwg) return false;
        int wgid = (int)L; { const int q = nwg / 8, r = nwg % 8, xcd = wgid % 8, o2 = wgid / 8; wgid = (xcd < r ? xcd * (q + 1) : r * (q + 1) + (xcd - r) * q) + o2; }
        const int tile = wgid / NTN; u.pn = wgid % NTN;
        int e = 0; for (int k = 0; k < NEX; ++k) e = (tp[k + 1] <= tile) ? k + 1 : e;
        u.e = e; u.pm = tile - tp[e]; u.srow0 = off[e] + 256 * u.pm; const int rem = cnt[e] - 256 * u.pm; u.nvalid = rem < 256 ? rem : 256; return true;
    }
    __device__ __forceinline__ const bf16* a_row(const Unit& u, int rl) const {
        if (gather) { const int tok = (rl < u.nvalid) ? list[u.e * LISTCAP + 256 * u.pm + rl] : 0; return A + (size_t)tok * K; }
        return A + (size_t)(u.srow0 + rl) * K;
    }
    __device__ __forceinline__ const bf16* b_row(const Unit& u, int cl) const { return Bt + (size_t)u.e * bstride + (size_t)(256 * u.pn + cl) * K; }
};

template <class Epi, class Sched>
__device__ __forceinline__ void gemm_phase_simple(const Sched& S, const Epi& E) {
    const int tid = threadIdx.x, wid = __builtin_amdgcn_readfirstlane(tid >> 6), lane = tid & 63, wr = wid >> 2, wc = wid & 3, fr = lane & 15, fq = lane >> 4;
    const int K = S.K;
    Unit u;
    for (int i = 0; S.next(i, u); ++i) {
        f32x4 acc[2][2][4][2];
#pragma unroll
        for (int a = 0; a < 2; ++a)
#pragma unroll
            for (int b = 0; b < 2; ++b)
#pragma unroll
                for (int m = 0; m < 4; ++m)
#pragma unroll
                    for (int n = 0; n < 2; ++n) acc[a][b][m][n] = (f32x4){0.f, 0.f, 0.f, 0.f};
        const bf16* ap[2][4]; const bf16* bp[2][2];
#pragma unroll
        for (int a = 0; a < 2; ++a)
#pragma unroll
            for (int m = 0; m < 4; ++m) ap[a][m] = S.a_row(u, 128 * a + 64 * wr + 16 * m + fr) + 8 * fq;
#pragma unroll
        for (int b = 0; b < 2; ++b)
#pragma unroll
            for (int n = 0; n < 2; ++n) bp[b][n] = S.b_row(u, 128 * b + 32 * wc + (Epi::PERM ? perm32(16 * n + fr) : (16 * n + fr))) + 8 * fq;
        for (int k0 = 0; k0 < K; k0 += 32) {
            bf16x8 Af[2][4], Bf[2][2];
#pragma unroll
            for (int a = 0; a < 2; ++a)
#pragma unroll
                for (int m = 0; m < 4; ++m) Af[a][m] = *(const bf16x8*)(ap[a][m] + k0);
#pragma unroll
            for (int b = 0; b < 2; ++b)
#pragma unroll
                for (int n = 0; n < 2; ++n) Bf[b][n] = *(const bf16x8*)(bp[b][n] + k0);
#pragma unroll
            for (int a = 0; a < 2; ++a)
#pragma unroll
                for (int b = 0; b < 2; ++b)
#pragma unroll
                    for (int m = 0; m < 4; ++m)
#pragma unroll
                        for (int n = 0; n < 2; ++n) acc[a][b][m][n] = __builtin_amdgcn_mfma_f32_16x16x32_bf16(Bf[b][n], Af[a][m], acc[a][b][m][n], 0, 0, 0);
        }
        E(acc, u, wr, wc, fr, fq);
    }
}

__device__ __forceinline__ u32x4 pack8(const f32x4 a, const f32x4 b) { return (u32x4){pk2(a.x, a.y), pk2(a.z, a.w), pk2(b.x, b.y), pk2(b.z, b.w)}; }
struct EpiProj {
    static constexpr bool PERM = true;
    bf16* P; const f32x2* rope;
    __device__ __forceinline__ void operator()(const f32x4 (&acc)[2][2][4][2], const Unit& u, int wr, int wc, int fr, int fq) const {
        const int row0 = u.pm * 256 + wr * 64 + fr, col0 = u.pn * 256 + wc * 32 + 8 * fq;
        const bool isq = (u.pn >= COL_Q / 256 && u.pn < COL_K / 256), isk = (u.pn >= COL_K / 256 && u.pn < COL_VA / 256);
        const float qs = isq ? 0.08838834764831845f : 1.0f;
#pragma unroll
        for (int ai = 0; ai < 2; ++ai)
#pragma unroll
            for (int m = 0; m < 4; ++m) { const int row = row0 + ai * 128 + m * 16; bf16* rowp = P + (size_t)row * INC + col0;
                f32x4 cs0 = {1.f, 0.f, 1.f, 0.f}, cs1 = {1.f, 0.f, 1.f, 0.f};
                if (isq || isk) { const f32x4* rp = (const f32x4*)(rope + (size_t)row * 64 + 16 * wc + 4 * fq); cs0 = rp[0]; cs1 = rp[1]; }
#pragma unroll
                for (int bj = 0; bj < 2; ++bj) { f32x4 t1 = acc[ai][bj][m][0], t2 = acc[ai][bj][m][1];
                    if (isq || isk) { const f32x4 co = {cs0.x, cs0.z, cs1.x, cs1.z}, si = {cs0.y, cs0.w, cs1.y, cs1.w};
                        const f32x4 o1 = (t1 * co - t2 * si) * qs, o2 = (t2 * co + t1 * si) * qs; t1 = o1; t2 = o2; }
                    *(u32x4*)(rowp + bj * 128) = pack8(t1, t2); } }
    }
};
template <bool ADD> struct EpiGate {
    static constexpr bool PERM = true;
    const bf16* P; int gcol; const bf16* prev; bf16* O;
    __device__ __forceinline__ void operator()(const f32x4 (&acc)[2][2][4][2], const Unit& u, int wr, int wc, int fr, int fq) const {
        const int row0 = u.pm * 256 + wr * 64 + fr, col0 = u.pn * 256 + wc * 32 + 8 * fq;
#pragma unroll
        for (int ai = 0; ai < 2; ++ai)
#pragma unroll
            for (int m = 0; m < 4; ++m) { const int row = row0 + ai * 128 + m * 16;
#pragma unroll
                for (int bj = 0; bj < 2; ++bj) { const int col = col0 + bj * 128;
                    const u32x4 gv = *(const u32x4*)(P + (size_t)row * INC + gcol + col);
                    f32x4 g0 = {bflo(gv.x), bfhi(gv.x), bflo(gv.y), bfhi(gv.y)}, g1 = {bflo(gv.z), bfhi(gv.z), bflo(gv.w), bfhi(gv.w)};
#pragma unroll
                    for (int j = 0; j < 4; ++j) { g0[j] = sigmoidf_(g0[j]); g1[j] = sigmoidf_(g1[j]); }
                    f32x4 o0 = g0 * acc[ai][bj][m][0], o1 = g1 * acc[ai][bj][m][1];
                    if (ADD) { const u32x4 pv = *(const u32x4*)(prev + (size_t)row * D + col);
                        o0 += (f32x4){bflo(pv.x), bfhi(pv.x), bflo(pv.y), bfhi(pv.y)}; o1 += (f32x4){bflo(pv.z), bfhi(pv.z), bflo(pv.w), bfhi(pv.w)}; }
                    *(u32x4*)(O + (size_t)row * D + col) = pack8(o0, o1); } }
    }
};
struct EpiX1 {
    static constexpr bool PERM = false;
    const float* x; const float* gate; float* O;
    __device__ __forceinline__ void operator()(const f32x4 (&acc)[2][2][4][2], const Unit& u, int wr, int wc, int fr, int fq) const {
        const int row0 = u.pm * 256 + wr * 64 + fr, col0 = u.pn * 256 + wc * 32 + 4 * fq; const int b = (u.pm * 256) / SEQ;
        f32x4 gv[2][2];
#pragma unroll
        for (int bj = 0; bj < 2; ++bj)
#pragma unroll
            for (int n = 0; n < 2; ++n) gv[bj][n] = *(const f32x4*)(gate + b * 6 * D + col0 + bj * 128 + n * 16);
#pragma unroll
        for (int ai = 0; ai < 2; ++ai)
#pragma unroll
            for (int m = 0; m < 4; ++m) { const size_t off = (size_t)(row0 + ai * 128 + m * 16) * D + col0;
#pragma unroll
                for (int bj = 0; bj < 2; ++bj)
#pragma unroll
                    for (int n = 0; n < 2; ++n) { const f32x4 xv = *(const f32x4*)(x + off + bj * 128 + n * 16);
                        *(f32x4*)(O + off + bj * 128 + n * 16) = xv + gv[bj][n] * acc[ai][bj][m][n]; } }
    }
};
struct EpiGU {
    static constexpr bool PERM = true;
    bf16* Hs;
    __device__ __forceinline__ void operator()(const f32x4 (&acc)[2][2][4][2], const Unit& u, int wr, int wc, int fr, int fq) const {
        const int j0 = u.pn * 128 + wc * 16 + 4 * fq;
#pragma unroll
        for (int ai = 0; ai < 2; ++ai)
#pragma unroll
            for (int m = 0; m < 4; ++m) { const int rl = ai * 128 + wr * 64 + m * 16 + fr;
                if (rl < u.nvalid) {
#pragma unroll
                    for (int bj = 0; bj < 2; ++bj) { const f32x4 g = acc[ai][bj][m][0], up = acc[ai][bj][m][1]; f32x4 h;
#pragma unroll
                        for (int j = 0; j < 4; ++j) h[j] = g[j] * sigmoidf_(g[j]) * up[j];
                        *(u32x2*)(Hs + (size_t)(u.srow0 + rl) * DE + j0 + bj * 64) = (u32x2){pk2(h.x, h.y), pk2(h.z, h.w)}; } } }
    }
};
struct EpiDown {
    static constexpr bool PERM = true;
    bf16* Y;
    __device__ __forceinline__ void operator()(const f32x4 (&acc)[2][2][4][2], const Unit& u, int wr, int wc, int fr, int fq) const {
        const int col0 = u.pn * 256 + wc * 32 + 8 * fq;
#pragma unroll
        for (int ai = 0; ai < 2; ++ai)
#pragma unroll
            for (int m = 0; m < 4; ++m) { const int rl = ai * 128 + wr * 64 + m * 16 + fr;
                if (rl < u.nvalid) {
#pragma unroll
                    for (int bj = 0; bj < 2; ++bj) *(u32x4*)(Y + (size_t)(u.srow0 + rl) * D + col0 + bj * 128) = pack8(acc[ai][bj][m][0], acc[ai][bj][m][1]); } }
    }
};

__device__ __forceinline__ void p3_attn_simple(Frame& F) {
    const int gw = F.vcu * NWAVES + F.wave, NGW = F.G * NWAVES;
    const bf16* P = (const bf16*)(F.ws + WS_PROJ); bf16* AO = (bf16*)(F.ws + WS_AO);
    LAS float* qb = (LAS float*)(F.lds + F.wave * 2048);
    LAS float* pb = qb + 128;
    const int lane = F.lane;
    for (int it = gw; it < NT * 4; it += NGW) { const int t = it >> 2, j = it & 3, s = t & (SEQ - 1);
        float Mx = -1e30f, Ss = 0.f, o0 = 0.f, o1 = 0.f;
        for (int g = 0; g < 3; ++g) { const int r = (g == 0) ? 1 : (g == 1 ? 4 : 16); const int head = 4 * g + j;
            const int nk = ((s / r) < 128 ? (s / r) : 128) + 1;
            { const unsigned qv = *(const unsigned*)(P + (size_t)t * INC + COL_Q + head * HD + 2 * lane); qb[2 * lane] = bflo(qv); qb[2 * lane + 1] = bfhi(qv); }
            LDS_WAIT(); __builtin_amdgcn_wave_barrier();
            float sc[3];
#pragma unroll
            for (int rr = 0; rr < 3; ++rr) { const int m = lane + 64 * rr; const bool valid = (m < nk) && (rr < 2 || lane == 0); float d = 0.f;
                if (valid) { const u32x4* kp = (const u32x4*)(P + (size_t)(t - m * r) * INC + COL_K + head * HD);
#pragma unroll 4
                    for (int c8 = 0; c8 < 16; ++c8) { const u32x4 kv = kp[c8]; const LAS f32x4* qq = (const LAS f32x4*)(qb + 8 * c8); const f32x4 q0 = qq[0], q1 = qq[1];
                        d += bflo(kv.x) * q0.x + bfhi(kv.x) * q0.y + bflo(kv.y) * q0.z + bfhi(kv.y) * q0.w + bflo(kv.z) * q1.x + bfhi(kv.z) * q1.y + bflo(kv.w) * q1.z + bfhi(kv.w) * q1.w; } }
                sc[rr] = valid ? d : -1e30f; }
            const float mg = wave_max(fmaxf(fmaxf(sc[0], sc[1]), sc[2]));
            float ps = 0.f;
#pragma unroll
            for (int rr = 0; rr < 3; ++rr) { const int m = lane + 64 * rr; const float p = (sc[rr] > -1e29f) ? __expf(sc[rr] - mg) : 0.f; ps += p; if (rr < 2 || lane == 0) pb[m] = p; }
            const float sg = wave_sum(ps);
            LDS_WAIT(); __builtin_amdgcn_wave_barrier();
            float a0 = 0.f, a1 = 0.f;
            const bf16* vp = P + (size_t)t * INC + COL_VA + head * HD + 2 * lane;
            for (int m = 0; m < nk; ++m) { const float p = pb[m]; const unsigned vv = *(const unsigned*)(vp - (size_t)m * r * INC); a0 += p * bflo(vv); a1 += p * bfhi(vv); }
            const float Mn = fmaxf(Mx, mg), so = __expf(Mx - Mn), sn = __expf(mg - Mn);
            o0 = o0 * so + a0 * sn; o1 = o1 * so + a1 * sn; Ss = Ss * so + sg * sn; Mx = Mn;
            LDS_WAIT(); __builtin_amdgcn_wave_barrier();
        }
        const float inv = 1.0f / Ss;
        *(unsigned*)(AO + (size_t)t * AOW + j * HD + 2 * lane) = pk2(o0 * inv, o1 * inv);
    }
}
__device__ __forceinline__ void p3_conv(Frame& F) {
    const bf16* P = (const bf16*)(F.ws + WS_PROJ); bf16* CG = (bf16*)(F.ws + WS_CG);
    for (int idx = F.vcu * NTHREADS + F.tid; idx < NT * 128; idx += F.G * NTHREADS) { const int t = idx >> 7, c8 = (idx & 127) * 8, s = t & (SEQ - 1);
        const bf16* pr = P + (size_t)t * INC + c8;
        const u32x4 bv = *(const u32x4*)(pr + COL_B);
        float u[3][8];
#pragma unroll
        for (int d = 0; d < 3; ++d) {
            if (s >= d) { const u32x4 cv = *(const u32x4*)(pr - (size_t)d * INC + COL_C), vv = *(const u32x4*)(pr - (size_t)d * INC + COL_V);
                u[d][0] = bflo(cv.x) * bflo(vv.x); u[d][1] = bfhi(cv.x) * bfhi(vv.x); u[d][2] = bflo(cv.y) * bflo(vv.y); u[d][3] = bfhi(cv.y) * bfhi(vv.y);
                u[d][4] = bflo(cv.z) * bflo(vv.z); u[d][5] = bfhi(cv.z) * bfhi(vv.z); u[d][6] = bflo(cv.w) * bflo(vv.w); u[d][7] = bfhi(cv.w) * bfhi(vv.w); }
            else {
#pragma unroll
                for (int k = 0; k < 8; ++k) u[d][k] = 0.f; } }
        float bb[8] = {bflo(bv.x), bfhi(bv.x), bflo(bv.y), bfhi(bv.y), bflo(bv.z), bfhi(bv.z), bflo(bv.w), bfhi(bv.w)};
        float o[8];
#pragma unroll
        for (int k = 0; k < 8; ++k) { const float w2 = F.conv_w[2 * CONVW + c8 + k], w1 = F.conv_w[CONVW + c8 + k], w0 = F.conv_w[c8 + k];
            o[k] = bb[k] * (w2 * u[0][k] + w1 * u[1][k] + w0 * u[2][k]); }
        *(u32x4*)(CG + (size_t)t * CONVW + c8) = (u32x4){pk2(o[0], o[1]), pk2(o[2], o[3]), pk2(o[4], o[5]), pk2(o[6], o[7])};
    }
}

__device__ __forceinline__ void p6_route(Frame& F) {
    const int gw = F.vcu * NWAVES + F.wave, NGW = F.G * NWAVES, lane = F.lane;
    const float* mod = (const float*)(F.ws + WS_MOD); const float* X1 = (const float*)(F.ws + WS_X1); bf16* H2 = (bf16*)(F.ws + WS_H2);
    int* tkid = (int*)(F.ws + WS_TKID); float* tkw = (float*)(F.ws + WS_TKW); int* tkpos = (int*)(F.ws + WS_TKPOS); int* list = (int*)(F.ws + WS_LIST);
    int* cnt = (int*)(F.ws + WS_CTL) + CW_CNT;
    LAS float* rb = (LAS float*)(F.lds + F.wave * 8192);
    const float rbias = F.router_bias[lane];
    for (int t = gw; t < NT; t += NGW) { const int b = t / SEQ;
        const f32x4* xr = (const f32x4*)(X1 + (size_t)t * D) + lane; f32x4 v[8]; float ss = 0.f;
#pragma unroll
        for (int j = 0; j < 8; ++j) { v[j] = xr[64 * j]; ss += (v[j].x * v[j].x + v[j].y * v[j].y) + (v[j].z * v[j].z + v[j].w * v[j].w); }
        const float rstd = rsqrtf(wave_sum(ss) * (1.f / D) + EPS);
        u32x2* o = (u32x2*)(H2 + (size_t)t * D) + lane;
#pragma unroll
        for (int j = 0; j < 8; ++j) { const int col = 4 * lane + 256 * j;
            const f32x4 g = *(const f32x4*)(F.norm_ffn_g + col), sh = *(const f32x4*)(mod + b * 6 * D + 3 * D + col), sc = *(const f32x4*)(mod + b * 6 * D + 4 * D + col);
            const f32x4 y = v[j] * rstd * g * (sc + 1.0f) + sh;
            o[64 * j] = (u32x2){pk2(y.x, y.y), pk2(y.z, y.w)};
            *(LAS f32x4*)(rb + col) = y; }
        LDS_WAIT(); __builtin_amdgcn_wave_barrier();
        float l0 = 0.f, l1 = 0.f, l2 = 0.f, l3 = 0.f;
        const float* wr_ = F.w_router + lane;
#pragma unroll 4
        for (int k = 0; k < D; k += 4) { const f32x4 hv = *(const LAS f32x4*)(rb + k);
            l0 += hv.x * wr_[(size_t)(k + 0) * NE]; l1 += hv.y * wr_[(size_t)(k + 1) * NE]; l2 += hv.z * wr_[(size_t)(k + 2) * NE]; l3 += hv.w * wr_[(size_t)(k + 3) * NE]; }
        const float logit = (l0 + l1) + (l2 + l3);
        const float scv = sigmoidf_(logit), sel = scv + rbias;
        int rin = 0;
#pragma unroll
        for (int d = 1; d < 8; ++d) { const float ov = __shfl_xor(sel, d); const int oj = lane ^ d; rin += ((ov > sel) || (ov == sel && oj < lane)) ? 1 : 0; }
        float gs = rin < 2 ? sel : 0.f; gs += __shfl_xor(gs, 1); gs += __shfl_xor(gs, 2); gs += __shfl_xor(gs, 4);
        const int myg = lane >> 3; int grank = 0;
#pragma unroll
        for (int d = 1; d < 8; ++d) { const float ov = __shfl_xor(gs, d << 3); const int og = myg ^ d; grank += ((ov > gs) || (ov == gs && og < myg)) ? 1 : 0; }
        const float mv = (grank < 4) ? sel : -1e30f;
        int rank = 0;
#pragma unroll
        for (int d = 1; d < 64; ++d) { const float ov = __shfl_xor(mv, d); const int oj = lane ^ d; rank += ((ov > mv) || (ov == mv && oj < lane)) ? 1 : 0; }
        const bool chosen = rank < TOPK;
        const float wsum = wave_sum(chosen ? scv : 0.f);
        if (chosen) { const int pos = atomicAdd(cnt + lane, 1); list[lane * LISTCAP + pos] = t;
            tkid[t * 8 + rank] = lane; tkw[t * 8 + rank] = scv / wsum * 2.5f; tkpos[t * 8 + rank] = pos; }
        if (lane == 0) list[NE * LISTCAP + t] = t;
        LDS_WAIT(); __builtin_amdgcn_wave_barrier();
    }
}
__device__ __forceinline__ int moe_tables(Frame& F, LAS int*& tp, LAS int*& cn, LAS int*& of) {
    LAS int* base = (LAS int*)(F.lds + 131072 + 8192);
    cn = base; of = base + 80; tp = base + 160;
    const int* cnt = (const int*)(F.ws + WS_CTL) + CW_CNT;
    if (F.tid == 0) { int o = 0, tpx = 0; for (int e = 0; e < NEX; ++e) { const int c = (e < NE) ? __hip_atomic_load(cnt + e, __ATOMIC_RELAXED, __HIP_MEMORY_SCOPE_AGENT) : NT; cn[e] = c; of[e] = o; tp[e] = tpx; o += c; tpx += (c + 255) / 256; } tp[NEX] = tpx; }
    __syncthreads();
    return tp[NEX];
}

__device__ __forceinline__ void p9_final(Frame& F, const LAS int* of) {
    const int gw = F.vcu * NWAVES + F.wave, NGW = F.G * NWAVES, lane = F.lane;
    const float* mod = (const float*)(F.ws + WS_MOD); const float* X1 = (const float*)(F.ws + WS_X1); const bf16* Y = (const bf16*)(F.ws + WS_Y);
    const int* tkid = (const int*)(F.ws + WS_TKID); const float* tkw = (const float*)(F.ws + WS_TKW); const int* tkpos = (const int*)(F.ws + WS_TKPOS);
    for (int t = gw; t < NT; t += NGW) { const int b = t / SEQ;
        f32x4 m[8];
        { const u32x2* yr = (const u32x2*)(Y + (size_t)(of[NE] + t) * D) + lane;
#pragma unroll
          for (int j = 0; j < 8; ++j) { const u32x2 w = yr[64 * j]; m[j] = (f32x4){bflo(w.x), bfhi(w.x), bflo(w.y), bfhi(w.y)}; } }
        for (int k = 0; k < TOPK; ++k) { const int e = tkid[t * 8 + k]; const float wk = tkw[t * 8 + k]; const int row = of[e] + tkpos[t * 8 + k];
            const u32x2* yr = (const u32x2*)(Y + (size_t)row * D) + lane;
#pragma unroll
            for (int j = 0; j < 8; ++j) { const u32x2 w = yr[64 * j]; m[j] += (f32x4){bflo(w.x), bfhi(w.x), bflo(w.y), bfhi(w.y)} * wk; } }
        const f32x4* xr = (const f32x4*)(X1 + (size_t)t * D) + lane; float ss = 0.f;
#pragma unroll
        for (int j = 0; j < 8; ++j) { const int col = 4 * lane + 256 * j; const f32x4 g2 = *(const f32x4*)(mod + b * 6 * D + 5 * D + col);
            m[j] = xr[64 * j] + g2 * m[j]; ss += (m[j].x * m[j].x + m[j].y * m[j].y) + (m[j].z * m[j].z + m[j].w * m[j].w); }
        const float rstd = rsqrtf(wave_sum(ss) * (1.f / D) + EPS);
        f32x4* orow = (f32x4*)(F.out + (size_t)t * D) + lane;
#pragma unroll
        for (int j = 0; j < 8; ++j) { const int col = 4 * lane + 256 * j; orow[64 * j] = m[j] * rstd * *(const f32x4*)(F.norm_final_g + col); }
    }
}

struct Args { const void* in[21]; float* out; unsigned char* ws; int ph_lo, ph_hi; };
constexpr int N_PHASES = 10;

__global__ void __launch_bounds__(NTHREADS, 2) fwd(Args args) {
    extern __shared__ __attribute__((aligned(16))) unsigned char lds[];
    Frame F;
    F.lds = (LAS unsigned char*)lds;
    F.tid = threadIdx.x; F.lane = F.tid & 63; F.wave = __builtin_amdgcn_readfirstlane(F.tid >> 6);
    F.G = gridDim.x; { const int bx = blockIdx.x; F.vcu = (F.G % 8 == 0) ? (bx % 8) * (F.G / 8) + bx / 8 : bx; }
    F.ws = args.ws; F.out = args.out;
    F.x = (const float*)args.in[0]; F.c = (const float*)args.in[1]; F.positions = (const int*)args.in[2]; F.norm_mix_g = (const float*)args.in[3];
    F.w_ada = (const float*)args.in[4]; F.b_ada = (const float*)args.in[5]; F.w_in = (const float*)args.in[6]; F.conv_w = (const float*)args.in[7];
    F.w_conv_out = (const float*)args.in[8]; F.w_attn_out = (const float*)args.in[9]; F.w_o = (const float*)args.in[10]; F.norm_ffn_g = (const float*)args.in[11];
    F.w_router = (const float*)args.in[12]; F.router_bias = (const float*)args.in[13]; F.w_exp_gate = (const float*)args.in[14]; F.w_exp_up = (const float*)args.in[15];
    F.w_exp_down = (const float*)args.in[16]; F.w_sh_gate = (const float*)args.in[17]; F.w_sh_up = (const float*)args.in[18]; F.w_sh_down = (const float*)args.in[19];
    F.norm_final_g = (const float*)args.in[20];
    const int lo = args.ph_lo, hi = args.ph_hi;
#define IN(k) (lo <= (k) && (k) < hi)
    unsigned char* ws = F.ws;
    const float* mod = (const float*)(ws + WS_MOD);

    if (IN(0)) { p0_prologue(F); }
    if (IN(1)) { p1_hnorm(F); }
    if (IN(2)) {
        SchedPlain S; S.init((const bf16*)(ws + WS_H), (const bf16*)(ws + WS_WIN), NT, INC, D, F.G, (int)blockIdx.x);
        EpiProj E{(bf16*)(ws + WS_PROJ), (const f32x2*)(ws + WS_ROPE)};
        gemm_phase_simple(S, E);
    }
    if (IN(3)) { p3_attn_simple(F); p3_conv(F); }
    if (IN(4)) {
        { SchedPlain S; S.init((const bf16*)(ws + WS_CG), (const bf16*)(ws + WS_WC), NT, D, CONVW, F.G, (int)blockIdx.x);
          EpiGate<false> E{(const bf16*)(ws + WS_PROJ), COL_GC, nullptr, (bf16*)(ws + WS_T1)}; gemm_phase_simple(S, E); }
        { SchedPlain S; S.init((const bf16*)(ws + WS_AO), (const bf16*)(ws + WS_WA), NT, D, AOW, F.G, (int)blockIdx.x);
          EpiGate<true> E{(const bf16*)(ws + WS_PROJ), COL_GA, (const bf16*)(ws + WS_T1), (bf16*)(ws + WS_MG)}; gemm_phase_simple(S, E); }
    }
    if (IN(5)) {
        SchedPlain S; S.init((const bf16*)(ws + WS_MG), (const bf16*)(ws + WS_WO), NT, D, D, F.G, (int)blockIdx.x);
        EpiX1 E{F.x, mod + 2 * D, (float*)(ws + WS_X1)}; gemm_phase_simple(S, E);
    }
    if (IN(6)) { p6_route(F); }
    if (IN(7)) {
        LAS int *tp, *cn, *of; const int ntiles = moe_tables(F, tp, cn, of);
        SchedMoE S; S.A = (const bf16*)(ws + WS_H2); S.Bt = (const bf16*)(ws + WS_WGU); S.list = (const int*)(ws + WS_LIST); S.K = D; S.NTN = 4; S.G = F.G; S.c = (int)blockIdx.x;
        S.nwg = ntiles * 4; S.bstride = (size_t)1024 * D; S.gather = true; S.tp = tp; S.cnt = cn; S.off = of;
        EpiGU E{(bf16*)(ws + WS_HS)}; gemm_phase_simple(S, E);
    }
    if (IN(8)) {
        LAS int *tp, *cn, *of; const int ntiles = moe_tables(F, tp, cn, of);
        SchedMoE S; S.A = (const bf16*)(ws + WS_HS); S.Bt = (const bf16*)(ws + WS_WD); S.list = nullptr; S.K = DE; S.NTN = 8; S.G = F.G; S.c = (int)blockIdx.x;
        S.nwg = ntiles * 8; S.bstride = (size_t)D * DE; S.gather = false; S.tp = tp; S.cnt = cn; S.off = of;
        EpiDown E{(bf16*)(ws + WS_Y)}; gemm_phase_simple(S, E);
    }
    if (IN(9)) { LAS int *tp, *cn, *of; (void)moe_tables(F, tp, cn, of); p9_final(F, of); }
#undef IN
}

extern "C" void kernel_launch(void* const* d_in, const int* in_sizes, int n_in, void* d_out, int out_size, void* d_ws, size_t ws_size, hipStream_t stream) {
    static int grid = 0;
    if (grid == 0) {
        if (n_in != 21 || out_size != NT * D || ws_size < WS_END) { fprintf(stderr, "kernel_launch: unexpected shapes (n_in %d out %d ws %zu)\n", n_in, out_size, ws_size); grid = -1; return; }
        int dev = 0, cus = 0;
        if (hipGetDevice(&dev) != hipSuccess || hipDeviceGetAttribute(&cus, hipDeviceAttributeMultiprocessorCount, dev) != hipSuccess) { grid = -1; return; }
        if (hipFuncSetAttribute((const void*)fwd, hipFuncAttributeMaxDynamicSharedMemorySize, LDS_BYTES) != hipSuccess) { fprintf(stderr, "kernel_launch: hipFuncSetAttribute failed\n"); grid = -1; return; }
        (void)hipGetLastError();
        grid = cus;
    }
    if (grid < 0) return;
    (void)hipMemsetAsync((char*)d_ws + WS_CTL, 0, CTL_ZERO_BYTES, stream);
    Args a{};
    for (int i = 0; i < 21; ++i) a.in[i] = d_in[i];
    a.out = (float*)d_out; a.ws = (unsigned char*)d_ws;
    for (int ph = 0; ph < N_PHASES; ++ph) { a.ph_lo = ph; a.ph_hi = ph + 1; hipLaunchKernelGGL(fwd, dim3(grid), dim3(NTHREADS), LDS_BYTES, stream, a); }
}
```

```cpp
#include <hip/hip_runtime.h>
#include <cstdio>
#include <cstdint>

#define GAS __attribute__((address_space(1)))
#define LAS __attribute__((address_space(3)))
typedef unsigned short bf16;
typedef short bf16x8 __attribute__((ext_vector_type(8)));
typedef float f32x4 __attribute__((ext_vector_type(4)));
typedef float f32x2 __attribute__((ext_vector_type(2)));
typedef unsigned u32x4 __attribute__((ext_vector_type(4)));
typedef unsigned u32x2 __attribute__((ext_vector_type(2)));

constexpr int NB = 2, SEQ = 4096, NT = NB * SEQ, D = 2048;
constexpr int CONVW = 1024, ATTW = 1536, HD = 128, AOW = 512;
constexpr int INC = 3 * CONVW + 3 * ATTW + 2 * D;
constexpr int COL_B = 0, COL_C = 1024, COL_V = 2048, COL_Q = 3072, COL_K = 4608, COL_VA = 6144, COL_GC = 7680, COL_GA = 9728;
constexpr int NE = 64, NEX = 65  , TOPK = 8, DE = 512;
constexpr float EPS = 1e-6f;
constexpr int NWAVES = 8, NTHREADS = 512;
constexpr int LISTCAP = 8192;

constexpr size_t MiB = 1u << 20;
constexpr size_t WS_CTL = 0, CTL_ZERO_BYTES = 1 * MiB;
constexpr size_t WS_MOD = 1 * MiB;
constexpr size_t WS_WRH = 1 * MiB + 128 * 1024, WS_WRL = 1 * MiB + 384 * 1024;
constexpr size_t WS_ROPE = 2 * MiB;
constexpr size_t WS_TKID = 6 * MiB;
constexpr size_t WS_TKW = WS_TKID + 256 * 1024;
constexpr size_t WS_TKPOS = WS_TKW + 256 * 1024;
constexpr size_t WS_LIST = 7 * MiB;
constexpr size_t WS_WC = 10 * MiB;
constexpr size_t WS_WA = 14 * MiB;
constexpr size_t WS_WO = 16 * MiB;
constexpr size_t WS_WIN = 24 * MiB;
constexpr size_t WS_WGU = 70 * MiB;
constexpr size_t WS_WD = 330 * MiB;
constexpr size_t WS_X1 = 460 * MiB;
constexpr size_t WS_PROJ = 524 * MiB;
constexpr size_t WS_H2 = 524 * MiB;
constexpr size_t WS_HS = 556 * MiB;
constexpr size_t WS_Y = 708 * MiB;
constexpr size_t WS_H = 708 * MiB;
constexpr size_t WS_CG = 766 * MiB;
constexpr size_t WS_AO = 782 * MiB;
constexpr size_t WS_T1 = 790 * MiB;
constexpr size_t WS_MG = 822 * MiB;
constexpr size_t WS_END = 998 * MiB;
constexpr int CW_CNT = 16384, CNT_STRIDE = 64;
constexpr int CW_BAR = 4096;
constexpr int LDS_BARW = 147456 - 16;

constexpr int LDS_BYTES = 147456;

__device__ __forceinline__ unsigned f2bf(float f) { unsigned u = __builtin_bit_cast(unsigned, f); return (u + 0x7fffu + ((u >> 16) & 1u)) >> 16; }
__device__ __forceinline__ unsigned pk2(float lo, float hi) { unsigned r; asm("v_cvt_pk_bf16_f32 %0, %1, %2" : "=v"(r) : "v"(lo), "v"(hi)); return r; }
__device__ __forceinline__ float bflo(unsigned w) { return __builtin_bit_cast(float, w << 16); }
__device__ __forceinline__ float bfhi(unsigned w) { return __builtin_bit_cast(float, w & 0xffff0000u); }
__device__ __forceinline__ float bf1(bf16 v) { return __builtin_bit_cast(float, ((unsigned)v) << 16); }
__device__ __forceinline__ float wave_sum(float v) {
#pragma unroll
    for (int o = 1; o < 64; o <<= 1) v += __shfl_xor(v, o);
    return v;
}
__device__ __forceinline__ float wave_max(float v) {
#pragma unroll
    for (int o = 1; o < 64; o <<= 1) v = fmaxf(v, __shfl_xor(v, o));
    return v;
}
__device__ __forceinline__ float sigmoidf_(float v) { return 1.0f / (1.0f + __expf(-v)); }
__host__ __device__ __forceinline__ int perm32(int rho) { const int n = rho >> 4, i = rho & 15; return 8 * (i >> 2) + 4 * n + (i & 3); }
#define LDS_WAIT() asm volatile("s_waitcnt lgkmcnt(0)" ::: "memory")
typedef int i32x8 __attribute__((ext_vector_type(8)));
__device__ __forceinline__ unsigned pk4_fp8(float a, float b, float c, float d) { int w = __builtin_amdgcn_cvt_pk_fp8_f32(a, b, 0, false); w = __builtin_amdgcn_cvt_pk_fp8_f32(c, d, w, true); return (unsigned)w; }
constexpr float W8_SCALE = 32.0f;
constexpr int SCALE_W8 = 0x7a7a7a7a, SCALE_ONE = 0x7f7f7f7f;


#define XB_TMO      128
#define XB_XCNT(j)  (256  + 64 * (j))
#define XB_XSUB(j)  (1280 + 64 * (j))
#define XB_XGEN(j)  (2304 + 64 * (j))
#define XB_TOP      3328
#define XB_TOPGEN   3392
#define XCD_BAR_WORDS 3456
#define XB_SPIN_CAP (1u << 18)

__device__ __forceinline__ unsigned xb_ld(unsigned* p)              { return __hip_atomic_load(p, __ATOMIC_RELAXED, __HIP_MEMORY_SCOPE_AGENT); }
__device__ __forceinline__ unsigned xb_add(unsigned* p, unsigned v) { return __hip_atomic_fetch_add(p, v, __ATOMIC_RELAXED, __HIP_MEMORY_SCOPE_AGENT); }
__device__ __forceinline__ unsigned xb_xcc_id() { return (unsigned)__builtin_amdgcn_s_getreg((3 << 11) | 20) & 0xFu; }
#define XB_SPIN(cond, bar) do { unsigned _sp = 0; while (cond) { __builtin_amdgcn_s_sleep(1); \
    if ((++_sp & 255u) == 0u) { if (xb_ld(&(bar)[XB_TMO])) break; if (_sp > XB_SPIN_CAP) { atomicAdd(&(bar)[XB_TMO], 1u); break; } } } } while (0)

struct XcdBarrier {
    unsigned* bar; unsigned x;
    volatile LAS unsigned* st;
};
__device__ __forceinline__ XcdBarrier xcd_barrier_post(unsigned* bar, volatile LAS unsigned* st) {
    XcdBarrier b; b.bar = bar; b.x = xb_xcc_id(); b.st = st;
    if (threadIdx.x == 0) (void)xb_add(&bar[XB_XCNT(b.x)], 1u);
    return b;
}
__device__ __forceinline__ void xcd_barrier_complete(unsigned* bar, unsigned x, unsigned& nloc, unsigned& nx) {
    const unsigned G = gridDim.x * gridDim.y * gridDim.z;
    unsigned sum, cnt, mine, sp = 0u;
    for (;;) {
        sum = 0u; cnt = 0u; mine = 0u;
#pragma unroll
        for (unsigned j = 0; j < 16; ++j) { const unsigned c = xb_ld(&bar[XB_XCNT(j)]); sum += c; cnt += (c > 0u) ? 1u : 0u; mine = (j == x) ? c : mine; }
        if (sum == G) break;
        __builtin_amdgcn_s_sleep(1);
        if ((++sp & 255u) == 0u) { if (xb_ld(&bar[XB_TMO])) break; if (sp > XB_SPIN_CAP) { atomicAdd(&bar[XB_TMO], 1u); break; } }
    }
    nloc = mine > 0u ? mine : 1u; nx = cnt > 0u ? cnt : 1u;
}
__device__ __forceinline__ void xcd_barrier(const XcdBarrier& b) {
    asm volatile("s_waitcnt vmcnt(0)" ::: "memory");
    __syncthreads();
    if (threadIdx.x == 0) {
        unsigned* bar = b.bar;
        __builtin_amdgcn_s_waitcnt(0);
        unsigned nloc = b.st[0], nx = b.st[1];
        if (nloc == 0u) { xcd_barrier_complete(bar, b.x, nloc, nx); b.st[0] = nloc; b.st[1] = nx; }
        const unsigned old = xb_add(&bar[XB_XSUB(b.x)], 1u);
        const unsigned gen = old / nloc;
        if (old + 1u == (gen + 1u) * nloc) {
            __builtin_amdgcn_fence(__ATOMIC_RELEASE, "agent");
            asm volatile("s_waitcnt vmcnt(0)" ::: "memory");
            const unsigned og = xb_add(&bar[XB_TOP], 1u);
            const unsigned tg = og / nx;
            if (og + 1u == (tg + 1u) * nx) xb_add(&bar[XB_TOPGEN], 1u);
            else XB_SPIN(xb_ld(&bar[XB_TOPGEN]) == tg, bar);
            __builtin_amdgcn_fence(__ATOMIC_ACQUIRE, "agent");
            xb_add(&bar[XB_XGEN(b.x)], 1u);
            asm volatile("s_waitcnt vmcnt(0)" ::: "memory");
        } else {
            XB_SPIN(xb_ld(&bar[XB_XGEN(b.x)]) == gen, bar);
            __builtin_amdgcn_fence(__ATOMIC_ACQUIRE, "agent");
            asm volatile("s_waitcnt vmcnt(0)" ::: "memory");
        }
    }
    __syncthreads();
}

struct Frame {
    LAS unsigned char* lds;
    int tid, lane, wave, vcu, G;
    unsigned char* ws;
    const float *x, *c, *norm_mix_g, *w_ada, *b_ada, *w_in, *conv_w, *w_conv_out, *w_attn_out, *w_o, *norm_ffn_g, *w_router, *router_bias,
        *w_exp_gate, *w_exp_up, *w_exp_down, *w_sh_gate, *w_sh_up, *w_sh_down, *norm_final_g;
    const int* positions;
    float* out;
};

struct TItem { const float* src; bf16* dst; int N, K, row_off, ilv, dd0, fp8; };
__device__ __forceinline__ TItem titem_make(const float* W, int K, int N, bf16* WT, int item, int mode  , int row_off2) {
    const int nblk = N / 32, kb = item / nblk, nb = item % nblk, k0 = 64 * kb, n0 = 32 * nb;
    TItem t; t.src = W + (size_t)k0 * N + n0; t.dst = WT + k0; t.N = N; t.K = K; t.row_off = n0; t.ilv = 0; t.dd0 = 0; t.fp8 = 0;
    if (mode == 1) { t.row_off = row_off2; t.ilv = 1; t.dd0 = n0; }
    else if (mode == 2 && n0 >= COL_Q && n0 < COL_VA) { const int hn = (n0 - COL_Q) & 127, hb = n0 - hn; t.row_off = hb + ((hn >= 64) ? 4 : 0); t.ilv = 1; t.dd0 = hn & 63; }
    return t;
}
constexpr int P0_S_IN = 46 * 32, P0_S_CO = 8 * 16, P0_S_AO = 8 * 8, P0_S_WO = 8 * 32, P0_S_EX = 2 * 32 + 2 * 32 + 8 * 8, P0_NSTEPS = P0_S_IN + P0_S_CO + P0_S_AO + P0_S_WO + 65 * P0_S_EX;
__device__ __forceinline__ TItem titem_step(Frame& F, int s, int w) {
    if (s < P0_S_IN) { const int sc = s >> 5, kb = s & 31; TItem t = titem_make(F.w_in, D, INC, (bf16*)(F.ws + WS_WIN), kb * (INC / 32) + 8 * sc + w, 2, 0);
        t.fp8 = 1; t.dst = (bf16*)(F.ws + WS_WIN + 64 * kb); return t; } s -= P0_S_IN;
    if (s < P0_S_CO) { const int sc = s >> 4, kb = s & 15; TItem t = titem_make(F.w_conv_out, CONVW, D, (bf16*)(F.ws + WS_WC), kb * 64 + 8 * sc + w, 0, 0); t.fp8 = 1; t.dst = (bf16*)(F.ws + WS_WC + 64 * kb); return t; } s -= P0_S_CO;
    if (s < P0_S_AO) { const int sc = s >> 3, kb = s & 7; TItem t = titem_make(F.w_attn_out, AOW, D, (bf16*)(F.ws + WS_WA), kb * 64 + 8 * sc + w, 0, 0); t.fp8 = 1; t.dst = (bf16*)(F.ws + WS_WA + 64 * kb); return t; } s -= P0_S_AO;
    if (s < P0_S_WO) { const int sc = s >> 5, kb = s & 31; TItem t = titem_make(F.w_o, D, D, (bf16*)(F.ws + WS_WO), kb * 64 + 8 * sc + w, 0, 0); t.fp8 = 1; t.dst = (bf16*)(F.ws + WS_WO + 64 * kb); return t; } s -= P0_S_WO;
    const int e = s / P0_S_EX; int q = s % P0_S_EX;
    unsigned char* wgu = F.ws + WS_WGU + (size_t)e * 1024 * D; unsigned char* wd = F.ws + WS_WD + (size_t)e * D * DE;
    TItem t;
    if (q < 128) { const bool up = q >= 64; q &= 63; const int sc = q >> 5, kb = q & 31;
        const float* sp = up ? ((e < NE) ? F.w_exp_up + (size_t)e * D * DE : F.w_sh_up) : ((e < NE) ? F.w_exp_gate + (size_t)e * D * DE : F.w_sh_gate);
        t = titem_make(sp, D, DE, (bf16*)wgu, kb * 16 + 8 * sc + w, 1, up ? 4 : 0); t.dst = (bf16*)(wgu + 64 * kb); }
    else { q -= 128; const int sc = q >> 3, kb = q & 7;
        t = titem_make((e < NE) ? F.w_exp_down + (size_t)e * DE * D : F.w_sh_down, DE, D, (bf16*)wd, kb * 64 + 8 * sc + w, 0, 0); t.dst = (bf16*)(wd + 64 * kb); }
    t.fp8 = 1; return t;
}

constexpr int P0_S_MIX = P0_S_IN + P0_S_CO + P0_S_AO + P0_S_WO;
__device__ __forceinline__ void titem_load(const TItem& t, f32x4 (&v)[8], int lane) {
#pragma unroll
    for (int i = 0; i < 8; ++i) v[i] = __builtin_nontemporal_load((const f32x4*)(t.src + (size_t)(8 * i + (lane >> 3)) * t.N + 4 * (lane & 7)));
}
__device__ __forceinline__ void titem_flush(const f32x4 (&v)[8], LAS float* scr, int lane) {
#pragma unroll
    for (int i = 0; i < 8; ++i) { LAS float* p = scr + (8 * i + (lane >> 3)) * 33 + 4 * (lane & 7); p[0] = v[i].x; p[1] = v[i].y; p[2] = v[i].z; p[3] = v[i].w; }
    LDS_WAIT(); asm volatile("" ::: "memory");
}
__device__ __forceinline__ void titem_emit(const TItem& t, const LAS float* scr, int lane) {
    const int c = lane & 7;
#pragma unroll
    for (int j = 0; j < 4; ++j) { const int n = (lane >> 3) + 8 * j; const LAS float* s = scr + (8 * c) * 33 + n;
        const int dd = t.dd0 + n; const int drow = t.ilv ? (t.row_off + ((dd >> 2) << 3) + (dd & 3)) : (t.row_off + n);
        if (t.fp8) { const u32x2 o8 = {pk4_fp8(s[0 * 33] * W8_SCALE, s[1 * 33] * W8_SCALE, s[2 * 33] * W8_SCALE, s[3 * 33] * W8_SCALE), pk4_fp8(s[4 * 33] * W8_SCALE, s[5 * 33] * W8_SCALE, s[6 * 33] * W8_SCALE, s[7 * 33] * W8_SCALE)};
            __builtin_nontemporal_store(o8, (u32x2*)((unsigned char*)t.dst + (size_t)drow * t.K + 8 * c)); }
        else { u32x4 o; o.x = pk2(s[0 * 33], s[1 * 33]); o.y = pk2(s[2 * 33], s[3 * 33]); o.z = pk2(s[4 * 33], s[5 * 33]); o.w = pk2(s[6 * 33], s[7 * 33]);
            *(u32x4*)(t.dst + (size_t)drow * t.K + 8 * c) = o; } }
    LDS_WAIT(); asm volatile("" ::: "memory");
}
__device__ __forceinline__ void convert_steps(Frame& F, int s_lo, int s_hi, LAS float* scr) {
    const int lane = F.lane, w = F.wave;
    const int n = s_hi - s_lo; if (n <= 0) return;
    const int last = s_hi - 1;
    constexpr int NSL = 1;
    int idx[NSL]; TItem t[NSL]; f32x4 v[NSL][8];
#pragma unroll
    for (int q = 0; q < NSL; ++q) { idx[q] = (s_lo + q < last) ? s_lo + q : last; t[q] = titem_step(F, idx[q], w); titem_load(t[q], v[q], lane); }
    const int iters = (n + NSL - 1) / NSL;
    for (int p = 0; p < iters; ++p) {
#pragma unroll
        for (int q = 0; q < NSL; ++q) {
            titem_flush(v[q], scr, lane);
            const int nx = (idx[q] + NSL < last) ? idx[q] + NSL : last; const TItem tn = titem_step(F, nx, w);
            titem_load(tn, v[q], lane);
            titem_emit(t[q], scr, lane);
            t[q] = tn; idx[q] = nx;
        }
    }
}


struct XDec { const float* src; unsigned char* dst; int N, KBD, rowmul; };
__device__ __forceinline__ XDec xdec(const Frame& F, int s, int w) {
    const int e = s / P0_S_EX; int q = s % P0_S_EX; XDec d;
    if (q < 128) { const bool up = q >= 64; q &= 63; const int sc = q >> 5, kb = q & 31, n0 = 32 * (8 * sc + w), k0 = 64 * kb;
        const float* sp = up ? ((e < NE) ? F.w_exp_up + (size_t)e * D * DE : F.w_sh_up) : ((e < NE) ? F.w_exp_gate + (size_t)e * D * DE : F.w_sh_gate);
        d.src = sp + (size_t)k0 * DE + n0; d.dst = F.ws + WS_WGU + (size_t)e * 1024 * D + (size_t)((up ? 4 : 0) + 2 * n0) * D + k0; d.N = DE; d.KBD = D; d.rowmul = 8; }
    else { q -= 128; const int sc = q >> 3, kb = q & 7, n0 = 32 * (8 * sc + w), k0 = 64 * kb;
        d.src = ((e < NE) ? F.w_exp_down + (size_t)e * DE * D : F.w_sh_down) + (size_t)k0 * D + n0; d.dst = F.ws + WS_WD + (size_t)e * D * DE + (size_t)n0 * DE + k0; d.N = D; d.KBD = DE; d.rowmul = 4; }
    return d;
}
__device__ __forceinline__ void xload(const XDec& d, f32x4 (&v)[8], int lane) {
    const int q = lane >> 3, lane_off = ((q & 6) + 8 * (q & 1)) * d.N + 4 * (lane & 7);
#pragma unroll
    for (int i = 0; i < 8; ++i) v[i] = __builtin_nontemporal_load((const f32x4*)(d.src + (size_t)((16 * (i >> 1) + (i & 1)) * d.N) + lane_off));
}
__device__ __forceinline__ void xproc(const XDec& d, const f32x4 (&v)[8], LAS unsigned char* tile, int lane) {
    const int wlo = lane * 16;
#pragma unroll
    for (int i = 0; i < 8; ++i) *(LAS f32x4*)(tile + i * 1024 + (((i >> 1) & 1) ? (wlo ^ 64) : wlo)) = v[i];
    LDS_WAIT(); asm volatile("" ::: "memory");
    const int c = lane & 7, np = lane >> 3, rbase = (16 * (c >> 1) + (c & 1)) * 128 + ((np ^ (4 * ((c >> 1) & 1))) * 16);
    f32x4 r[8];
#pragma unroll
    for (int k = 0; k < 8; ++k) r[k] = *(const LAS f32x4*)(tile + rbase + ((k & 6) + 8 * (k & 1)) * 128);
    LDS_WAIT(); asm volatile("" ::: "memory");
    unsigned char* dp = d.dst + (size_t)(np * d.rowmul * d.KBD + 8 * c);
#pragma unroll
    for (int jj = 0; jj < 4; ++jj) {
        const u32x2 o8 = {pk4_fp8(r[0][jj] * W8_SCALE, r[1][jj] * W8_SCALE, r[2][jj] * W8_SCALE, r[3][jj] * W8_SCALE), pk4_fp8(r[4][jj] * W8_SCALE, r[5][jj] * W8_SCALE, r[6][jj] * W8_SCALE, r[7][jj] * W8_SCALE)};
        __builtin_nontemporal_store(o8, (u32x2*)(dp + (size_t)(jj * d.KBD))); }
}
__device__ __forceinline__ void convert_experts(Frame& F, int s_lo, int s_hi, LAS unsigned char* tile) {
    if (s_hi <= s_lo) return;
    const int lane = F.lane, w = __builtin_amdgcn_readfirstlane(F.wave), last = s_hi - 1;
    f32x4 va[8], vb[8];
    XDec d0 = xdec(F, s_lo, w); xload(d0, va, lane);
    for (int s = s_lo; s < s_hi; s += 2) {
        const XDec d1 = xdec(F, (s + 1 < last) ? s + 1 : last, w); xload(d1, vb, lane);
        xproc(d0, va, tile, lane);
        const XDec d2 = xdec(F, (s + 2 < last) ? s + 2 : last, w); xload(d2, va, lane);
        xproc(d1, vb, tile, lane);
        d0 = d2;
    }
}

__device__ __forceinline__ void p0_prologue(Frame& F) {
    const int gw = F.vcu * NWAVES + F.wave, NGW = F.G * NWAVES, lane = F.lane;
    {
        LAS float* red = (LAS float*)(F.lds);
        for (int cc = F.vcu; cc < 256; cc += F.G) {
            const int g = lane / 12, cs = lane % 12;
            f32x4 a0 = {0.f, 0.f, 0.f, 0.f}, a1 = {0.f, 0.f, 0.f, 0.f};
            if (g < 5) {
                const int rbase = 256 * F.wave;
                for (int ib = 0; ib < 4; ++ib) {
                    f32x4 w[13]; float s0[13], s1[13];
#pragma unroll
                    for (int u = 0; u < 13; ++u) { int rl = 5 * (13 * ib + u) + g; const bool ok = rl < 256; rl = ok ? rl : 255; const int r = rbase + rl;
                        w[u] = __builtin_nontemporal_load((const f32x4*)(F.w_ada + (size_t)r * (6 * D) + 48 * cc + 4 * cs)); const float c0 = F.c[r], c1 = F.c[D + r];
                        s0[u] = ok ? c0 * sigmoidf_(c0) : 0.f; s1[u] = ok ? c1 * sigmoidf_(c1) : 0.f; }
#pragma unroll
                    for (int u = 0; u < 13; ++u) { a0 += w[u] * s0[u]; a1 += w[u] * s1[u]; }
                }
            }
            LAS float* my = red + (F.wave * 64 + lane) * 8;
            my[0] = a0.x; my[1] = a0.y; my[2] = a0.z; my[3] = a0.w; my[4] = a1.x; my[5] = a1.y; my[6] = a1.z; my[7] = a1.w;
            __syncthreads();
            if (F.tid < 96) { const int b = F.tid / 48, col = F.tid % 48, cs2 = col >> 2, comp = col & 3; float s = 0.f;
                for (int w = 0; w < 8; ++w) for (int gg = 0; gg < 5; ++gg) s += red[(w * 64 + gg * 12 + cs2) * 8 + b * 4 + comp];
                ((float*)(F.ws + WS_MOD))[b * 6 * D + 48 * cc + col] = s + F.b_ada[48 * cc + col]; }
            __syncthreads();
        }
    }
    {
        f32x2* tab = (f32x2*)(F.ws + WS_ROPE);
        for (int idx = (F.vcu * NTHREADS + F.tid); idx < NT * 64; idx += F.G * NTHREADS) { const int tok = idx >> 6, i = idx & 63;
            const float inv = exp2f(-(float)i * (13.287712379549449f / 64.0f));
            const double rev = (double)F.positions[tok] * (double)inv * 0.15915494309189535; const float fr = (float)(rev - floor(rev));
            tab[idx] = (f32x2){__builtin_amdgcn_cosf(fr), __builtin_amdgcn_sinf(fr)}; }
    }
    {
        bf16* wrh = (bf16*)(F.ws + WS_WRH); bf16* wrl = (bf16*)(F.ws + WS_WRL);
        for (int idx = F.vcu * NTHREADS + F.tid; idx < NE * (D / 8); idx += F.G * NTHREADS) { const int e = idx / (D / 8), kc = idx % (D / 8);
            unsigned hw[4], lw[4];
#pragma unroll
            for (int i = 0; i < 4; ++i) { const float a = F.w_router[(size_t)(8 * kc + 2 * i) * NE + e], b = F.w_router[(size_t)(8 * kc + 2 * i + 1) * NE + e];
                const unsigned ha = f2bf(a), hb = f2bf(b); hw[i] = ha | (hb << 16); lw[i] = pk2(a - __builtin_bit_cast(float, ha << 16), b - __builtin_bit_cast(float, hb << 16)); }
            *(u32x4*)(wrh + (size_t)e * D + 8 * kc) = (u32x4){hw[0], hw[1], hw[2], hw[3]}; *(u32x4*)(wrl + (size_t)e * D + 8 * kc) = (u32x4){lw[0], lw[1], lw[2], lw[3]}; }
    }
    convert_steps(F, (int)(((long)F.vcu * P0_S_MIX) / F.G), (int)(((long)(F.vcu + 1) * P0_S_MIX) / F.G), (LAS float*)(F.lds + 16384 + F.wave * 16384));
}

__device__ __forceinline__ void p1_hnorm(Frame& F) {
    const int gw = F.vcu * NWAVES + F.wave, NGW = F.G * NWAVES;
    const float* mod = (const float*)(F.ws + WS_MOD); unsigned char* H = F.ws + WS_H;
    for (int t0 = gw; t0 < NT; t0 += 2 * NGW) {
        f32x4 v[2][8]; int tt[2];
#pragma unroll
        for (int k = 0; k < 2; ++k) { tt[k] = (t0 + k * NGW < NT) ? t0 + k * NGW : t0; const f32x4* xr = (const f32x4*)(F.x + (size_t)tt[k] * D) + F.lane;
#pragma unroll
            for (int j = 0; j < 8; ++j) v[k][j] = __builtin_nontemporal_load(xr + 64 * j); }
#pragma unroll
        for (int k = 0; k < 2; ++k) { const int t = tt[k], b = t / SEQ; float ss = 0.f;
#pragma unroll
            for (int j = 0; j < 8; ++j) ss += (v[k][j].x * v[k][j].x + v[k][j].y * v[k][j].y) + (v[k][j].z * v[k][j].z + v[k][j].w * v[k][j].w);
            const float rstd = rsqrtf(wave_sum(ss) * (1.f / D) + EPS);
            unsigned* o = (unsigned*)(H + (size_t)t * D) + F.lane;
            if (k == 0 || t0 + NGW < NT) {
#pragma unroll
                for (int j = 0; j < 8; ++j) { const int col = 4 * F.lane + 256 * j;
                    const f32x4 g = *(const f32x4*)(F.norm_mix_g + col), sh = *(const f32x4*)(mod + b * 6 * D + col), sc = *(const f32x4*)(mod + b * 6 * D + D + col);
                    const f32x4 y = v[k][j] * rstd * g * (sc + 1.0f) + sh;
                    o[64 * j] = pk4_fp8(y.x, y.y, y.z, y.w); } }
        }
    }
}

struct Unit { int pm, pn, e, srow0, nvalid, ord; };

struct SchedPlain {
    const bf16* A; const bf16* Bt; int K, KB; int nM, nN, nwg, G, c; int gs = 8;
    __device__ __forceinline__ void init(const bf16* A_, const bf16* Bt_, int M, int N, int K_, int G_, int c_) { A = A_; Bt = Bt_; K = K_; KB = 2 * K_; nM = M / 256; nN = N / 256; nwg = nM * nN; G = G_; c = c_; }
    __device__ __forceinline__ bool next(int i, Unit& u) const {
        const long L = (long)i * G + c; if (L >= nwg) return false;
        int wgid = (int)L; { const int q = nwg / 8, r = nwg % 8, xcd = wgid % 8, off = wgid / 8; wgid = (xcd < r ? xcd * (q + 1) : r * (q + 1) + (xcd - r) * q) + off; }
        const int nig = gs * nN, gid = wgid / nig, fm = gid * gs, gsz = (nM - fm) < gs ? (nM - fm) : gs;
        u.pm = fm + ((wgid % nig) % gsz); u.pn = (wgid % nig) / gsz; u.e = 0; u.srow0 = 256 * u.pm; u.nvalid = 256; u.ord = i; return true;
    }
    __device__ __forceinline__ const char* a_base(const Unit& u) const { return (const char*)(A + (size_t)(256 * u.pm) * K); }
    __device__ __forceinline__ const char* b_base(const Unit& u) const { return (const char*)(Bt + (size_t)(256 * u.pn) * K); }
    __device__ __forceinline__ void a_offs(const Unit&, const int (&R)[2], const int (&C)[2], unsigned (&v)[2][2]) const {
#pragma unroll
        for (int h = 0; h < 2; ++h)
#pragma unroll
            for (int i = 0; i < 2; ++i) v[h][i] = (unsigned)((R[i] + 128 * h) * K + C[i]) * 2u; }
};
struct SchedMoE {
    const unsigned char* A; const unsigned char* Bt; const int* list; int KB, NTN, G, c, nwg; size_t bstride; bool gather;
    const LAS int* ll;
    const LAS int* tp; const LAS int* cnt; const LAS int* off;
    __device__ __forceinline__ bool next(int i, Unit& u) const {
        const long L = (long)i * G + c; if (L >= nwg) return false;
        int wgid = (int)L; { const int q = nwg / 8, r = nwg % 8, xcd = wgid % 8, o2 = wgid / 8; wgid = (xcd < r ? xcd * (q + 1) : r * (q + 1) + (xcd - r) * q) + o2; }
        const int tile = wgid / NTN; u.pn = wgid % NTN;
        int e = 0;
#pragma unroll
        for (int st = 64; st >= 1; st >>= 1) { const int c2 = e + st; if (c2 <= NE && tp[c2] <= tile) e = c2; }
        u.e = e; u.pm = tile - tp[e]; u.srow0 = off[e] + 256 * u.pm; const int rem = cnt[e] - 256 * u.pm; u.nvalid = rem < 256 ? rem : 256; u.ord = i; return true;
    }
    __device__ __forceinline__ const char* a_base(const Unit& u) const { return gather ? (const char*)A : (const char*)(A + (size_t)u.srow0 * KB); }
    __device__ __forceinline__ const char* b_base(const Unit& u) const { return (const char*)(Bt + (size_t)u.e * bstride + (size_t)(256 * u.pn) * KB); }
    __device__ __forceinline__ void a_offs(const Unit& u, const int (&R)[2], const int (&C)[2], unsigned (&v)[2][2]) const {
#pragma unroll
        for (int h = 0; h < 2; ++h)
#pragma unroll
            for (int i = 0; i < 2; ++i) { const int rl = R[i] + 128 * h; int row = rl;
                if (gather) row = ll[u.ord * 256 + rl];
                v[h][i] = (unsigned)(row * KB + C[i] * 2); } }
};

constexpr int HTB = 128 * 64 * 2;
__device__ __forceinline__ int lds_byte(int r, int c) { const int st = (r >> 4) * 2 + (c >> 5), rr = r & 15, cc = c & 31, ob = rr * 64 + cc * 2; return st * 1024 + (ob ^ (((ob >> 9) & 1) << 5)); }
__device__ __forceinline__ void stage_rc(int b, int& R, int& C) { const int st = b / 1024, sb = b % 1024, swz = sb ^ (((sb >> 9) & 1) << 5); R = (st >> 1) * 16 + swz / 64; C = (st & 1) * 32 + (swz % 64) / 2; }

template <class Epi, class Sched, bool ALIGN_EPI, bool FP8>
__device__ __forceinline__ void gemm_phase(LAS unsigned char* lds, const Sched& S, const Epi& E) {
    const int tid = threadIdx.x, wid = __builtin_amdgcn_readfirstlane(tid >> 6), lane = tid & 63, wr = wid >> 2, wc = wid & 3, fr = lane & 15, fq = lane >> 4;
    const int K = S.KB / 2, nt = S.KB / 128;
    int Rr[2], Cc[2]; unsigned voffB[2];
#pragma unroll
    for (int i = 0; i < 2; ++i) { stage_rc(tid * 16 + i * 8192, Rr[i], Cc[i]); int Rb = Epi::PERM ? ((Rr[i] & ~31) + perm32(Rr[i] & 31)) : Rr[i];
        if constexpr (Epi::WIDE) Rb = (Rr[i] >> 5) * 64 + 16 * ((Rr[i] & 15) >> 2) + 4 * ((Rr[i] >> 4) & 1) + (Rr[i] & 3);
        voffB[i] = (unsigned)(Rb * K + Cc[i]) * 2u; }
    const size_t kstep = (size_t)(64 * 2);
    const size_t hstep = (size_t)(Epi::WIDE ? 8 : 128) * K * 2;
    const unsigned ldsw = (unsigned)wid * 1024u;
    const int aoff = lds_byte(wr * 64 + fr, fq * 8), boff = lds_byte(wc * 32 + fr, fq * 8);
#define PG8_SA(b, h) (((b) * 2 + (h)) * HTB)
#define PG8_SB(b, h) ((4 + (b) * 2 + (h)) * HTB)
#define PG8_STAGE(bufoff, gbase, voff) do { _Pragma("unroll") for (int _i = 0; _i < 2; ++_i) \
        __builtin_amdgcn_global_load_lds((const unsigned*)((const char*)(gbase) + (voff)[_i]), (LAS unsigned*)(lds + (bufoff) + ldsw + _i * 8192), 16, 0, 0); } while (0)
#define PG8_LD8(p) __builtin_shufflevector(*(const LAS u32x4*)(p), *(const LAS u32x4*)((p) + 1024), 0, 1, 2, 3, 4, 5, 6, 7)
#define PG8_LDA(dst, b, h) do { if constexpr (FP8) { _Pragma("unroll") for (int m = 0; m < 4; ++m) dst##8[m] = PG8_LD8(lds + PG8_SA(b, h) + aoff + m * 2048); } \
        else { _Pragma("unroll") for (int m = 0; m < 4; ++m) _Pragma("unroll") for (int k = 0; k < 2; ++k) dst[m][k] = *(const LAS bf16x8*)(lds + PG8_SA(b, h) + aoff + m * 2048 + k * 1024); } } while (0)
#define PG8_LDB(dst, b, h) do { if constexpr (FP8) { _Pragma("unroll") for (int n = 0; n < 2; ++n) dst##8[n] = PG8_LD8(lds + PG8_SB(b, h) + boff + n * 2048); } \
        else { _Pragma("unroll") for (int n = 0; n < 2; ++n) _Pragma("unroll") for (int k = 0; k < 2; ++k) dst[n][k] = *(const LAS bf16x8*)(lds + PG8_SB(b, h) + boff + n * 2048 + k * 1024); } } while (0)
#define PG8_MMA(ai, bj, At, Bt) do { __builtin_amdgcn_s_setprio(1); _Pragma("unroll") for (int m = 0; m < 4; ++m) _Pragma("unroll") for (int n = 0; n < 2; ++n) { \
        if constexpr (FP8) asm volatile("v_mfma_scale_f32_16x16x128_f8f6f4 %0, %1, %2, %0, %3, %4 op_sel_hi:[0,0,0]" : "+v"(acc[ai][bj][m][n]) : "v"(Bt##8[n]), "v"(At##8[m]), "v"(sclW), "v"(sclO)); \
        else { _Pragma("unroll") for (int k = 0; k < 2; ++k) acc[ai][bj][m][n] = __builtin_amdgcn_mfma_f32_16x16x32_bf16(Bt[n][k], At[m][k], acc[ai][bj][m][n], 0, 0, 0); } } \
        __builtin_amdgcn_s_setprio(0); } while (0)
#define PG8_WAIT_V(n) asm volatile("s_waitcnt vmcnt(" #n ")" ::: "memory")
#define PG8_WAIT_L(n) asm volatile("s_waitcnt lgkmcnt(" #n ")" ::: "memory")
#define PG8_BAR __builtin_amdgcn_s_barrier()
#define PG8_SCHED __builtin_amdgcn_sched_barrier(0)
    Unit cur, nxt; int ui = 0;
    if (!S.next(0, cur)) return;
    f32x4 acc[2][2][4][2];
#pragma unroll
    for (int a = 0; a < 2; ++a)
#pragma unroll
        for (int b = 0; b < 2; ++b)
#pragma unroll
            for (int m = 0; m < 4; ++m)
#pragma unroll
                for (int n = 0; n < 2; ++n) acc[a][b][m][n] = (f32x4){0.f, 0.f, 0.f, 0.f};
    bf16x8 At[4][2], B0[2][2], B1[2][2];
    typedef unsigned u32x8 __attribute__((ext_vector_type(8)));
    u32x8 At8[4], B08[2], B18[2];
    int sclW = SCALE_W8, sclO = SCALE_ONE; asm volatile("" : "+v"(sclW), "+v"(sclO));
    unsigned vAc[2][2], vAn[2][2];
    S.a_offs(cur, Rr, Cc, vAc);
    const char* cA = S.a_base(cur); const char* cB = S.b_base(cur);
    PG8_STAGE(PG8_SB(0, 0), cB, voffB); PG8_STAGE(PG8_SB(0, 1), cB + hstep, voffB); PG8_STAGE(PG8_SA(0, 0), cA, vAc[0]); PG8_STAGE(PG8_SA(0, 1), cA, vAc[1]);
    if (wr == 1) PG8_BAR;
    PG8_WAIT_V(2); PG8_BAR;
    PG8_STAGE(PG8_SB(1, 0), cB + kstep, voffB); PG8_STAGE(PG8_SA(1, 0), cA + kstep, vAc[0]); PG8_STAGE(PG8_SB(1, 1), cB + hstep + kstep, voffB);
    PG8_WAIT_V(6); PG8_BAR;
    for (;;) {
        const bool has_next = S.next(ui + 1, nxt);
        const char* nA = has_next ? S.a_base(nxt) : cA; const char* nB = has_next ? S.b_base(nxt) : cB;
        if (has_next) S.a_offs(nxt, Rr, Cc, vAn);
        else {
#pragma unroll
            for (int h = 0; h < 2; ++h)
#pragma unroll
                for (int i = 0; i < 2; ++i) vAn[h][i] = vAc[h][i]; }
        for (int t = 0; t < nt; t += 2) {
            const bool last = (t == nt - 2);
            const char* a1 = cA + (size_t)(t + 1) * kstep;
            const char* a2 = last ? nA : cA + (size_t)(t + 2) * kstep; const char* b2 = last ? nB : cB + (size_t)(t + 2) * kstep;
            const char* a3 = a2 + kstep; const char* b3 = b2 + kstep;
            PG8_LDB(B0, 0, 0); PG8_LDB(B1, 0, 1); PG8_SCHED; PG8_LDA(At, 0, 0); PG8_STAGE(PG8_SA(1, 1), a1, vAc[1]);
            PG8_WAIT_V(8); PG8_WAIT_L(0); PG8_BAR; PG8_MMA(0, 0, At, B0); PG8_MMA(0, 1, At, B1); PG8_BAR; PG8_SCHED;
            if (last) {
#pragma unroll
                for (int h = 0; h < 2; ++h)
#pragma unroll
                    for (int i = 0; i < 2; ++i) { asm volatile("" : "+v"(vAn[h][i])); vAc[h][i] = vAn[h][i]; } }
            PG8_LDA(At, 0, 1); PG8_STAGE(PG8_SB(0, 0), b2, voffB); PG8_STAGE(PG8_SB(0, 1), b2 + hstep, voffB); PG8_STAGE(PG8_SA(0, 0), a2, vAc[0]);
            PG8_WAIT_V(8); PG8_WAIT_L(0); PG8_BAR; if (cur.nvalid > 128) { PG8_MMA(1, 0, At, B0); PG8_MMA(1, 1, At, B1); } PG8_BAR; PG8_SCHED;
            PG8_LDB(B0, 1, 0); PG8_LDB(B1, 1, 1); PG8_SCHED; PG8_LDA(At, 1, 0); PG8_STAGE(PG8_SA(0, 1), a2, vAc[1]);
            PG8_WAIT_V(8); PG8_WAIT_L(0); PG8_BAR; PG8_MMA(0, 0, At, B0); PG8_MMA(0, 1, At, B1); PG8_BAR; PG8_SCHED;
            PG8_LDA(At, 1, 1); PG8_STAGE(PG8_SB(1, 0), b3, voffB); PG8_STAGE(PG8_SB(1, 1), b3 + hstep, voffB); PG8_STAGE(PG8_SA(1, 0), a3, vAc[0]);
            PG8_WAIT_V(8); PG8_WAIT_L(0); PG8_BAR; if (cur.nvalid > 128) { PG8_MMA(1, 0, At, B0); PG8_MMA(1, 1, At, B1); } PG8_BAR; PG8_SCHED;
        }
        if constexpr (ALIGN_EPI) { if (wr == 0) PG8_BAR; }
        if constexpr (FP8) asm volatile("s_nop 15\n\ts_nop 15" ::: "memory");
        E(acc, cur, wr, wc, fr, fq);
        if (!has_next) break;
#pragma unroll
        for (int a = 0; a < 2; ++a)
#pragma unroll
            for (int b = 0; b < 2; ++b)
#pragma unroll
                for (int m = 0; m < 4; ++m)
#pragma unroll
                    for (int n = 0; n < 2; ++n) acc[a][b][m][n] = (f32x4){0.f, 0.f, 0.f, 0.f};
        cur = nxt; cA = nA; cB = nB; ++ui;
        if constexpr (ALIGN_EPI) { if (wr == 1) PG8_BAR; }
    }
    PG8_WAIT_V(0);
    if constexpr (!ALIGN_EPI) { if (wr == 0) PG8_BAR; }
    PG8_BAR;
#undef PG8_SA
#undef PG8_SB
#undef PG8_STAGE
#undef PG8_LDA
#undef PG8_LDB
#undef PG8_MMA
#undef PG8_WAIT_V
#undef PG8_WAIT_L
#undef PG8_BAR
#undef PG8_SCHED
}

__device__ __forceinline__ u32x4 pack8(const f32x4 a, const f32x4 b) { return (u32x4){pk2(a.x, a.y), pk2(a.z, a.w), pk2(b.x, b.y), pk2(b.z, b.w)}; }
struct EpiProj {
    static constexpr bool PERM = true, WIDE = false;
    bf16* P; const f32x2* rope;
    __device__ __forceinline__ void operator()(const f32x4 (&acc)[2][2][4][2], const Unit& u, int wr, int wc, int fr, int fq) const {
        const int row0 = u.pm * 256 + wr * 64 + fr, col0 = u.pn * 256 + wc * 32 + 8 * fq;
        const bool isq = (u.pn >= COL_Q / 256 && u.pn < COL_K / 256), isk = (u.pn >= COL_K / 256 && u.pn < COL_VA / 256);
        const float qs = isq ? 0.08838834764831845f : 1.0f;
#pragma unroll
        for (int ai = 0; ai < 2; ++ai)
#pragma unroll
            for (int m = 0; m < 4; ++m) { const int row = row0 + ai * 128 + m * 16; bf16* rowp = P + (size_t)row * INC + col0;
                f32x4 cs0 = {1.f, 0.f, 1.f, 0.f}, cs1 = {1.f, 0.f, 1.f, 0.f};
                if (isq || isk) { const f32x4* rp = (const f32x4*)(rope + (size_t)row * 64 + 16 * wc + 4 * fq); cs0 = rp[0]; cs1 = rp[1]; }
#pragma unroll
                for (int bj = 0; bj < 2; ++bj) { f32x4 t1 = acc[ai][bj][m][0], t2 = acc[ai][bj][m][1];
                    if (isq || isk) { const f32x4 co = {cs0.x, cs0.z, cs1.x, cs1.z}, si = {cs0.y, cs0.w, cs1.y, cs1.w};
                        const f32x4 o1 = (t1 * co - t2 * si) * qs, o2 = (t2 * co + t1 * si) * qs; t1 = o1; t2 = o2; }
                    *(u32x4*)(rowp + bj * 128) = pack8(t1, t2); } }
    }
};
template <bool ADD> struct EpiGate {
    static constexpr bool PERM = true, WIDE = false;
    const bf16* P; int gcol; const bf16* prev; bf16* O;
    __device__ __forceinline__ void operator()(const f32x4 (&acc)[2][2][4][2], const Unit& u, int wr, int wc, int fr, int fq) const {
        const int row0 = u.pm * 256 + wr * 64 + fr, col0 = u.pn * 256 + wc * 32 + 8 * fq;
#pragma unroll
        for (int ai = 0; ai < 2; ++ai)
#pragma unroll
            for (int m = 0; m < 4; ++m) { const int row = row0 + ai * 128 + m * 16;
#pragma unroll
                for (int bj = 0; bj < 2; ++bj) { const int col = col0 + bj * 128;
                    const u32x4 gv = *(const u32x4*)(P + (size_t)row * INC + gcol + col);
                    f32x4 g0 = {bflo(gv.x), bfhi(gv.x), bflo(gv.y), bfhi(gv.y)}, g1 = {bflo(gv.z), bfhi(gv.z), bflo(gv.w), bfhi(gv.w)};
#pragma unroll
                    for (int j = 0; j < 4; ++j) { g0[j] = sigmoidf_(g0[j]); g1[j] = sigmoidf_(g1[j]); }
                    f32x4 o0 = g0 * acc[ai][bj][m][0], o1 = g1 * acc[ai][bj][m][1];
                    if (ADD) { const u32x4 pv = *(const u32x4*)(prev + (size_t)row * D + col);
                        o0 += (f32x4){bflo(pv.x), bfhi(pv.x), bflo(pv.y), bfhi(pv.y)}; o1 += (f32x4){bflo(pv.z), bfhi(pv.z), bflo(pv.w), bfhi(pv.w)}; }
                    if constexpr (ADD) *(u32x2*)((unsigned char*)O + (size_t)row * D + col) = (u32x2){pk4_fp8(o0.x, o0.y, o0.z, o0.w), pk4_fp8(o1.x, o1.y, o1.z, o1.w)};
                    else *(u32x4*)(O + (size_t)row * D + col) = pack8(o0, o1); } }
    }
};
struct EpiX1 {
    static constexpr bool PERM = false, WIDE = false;
    const float* x; const float* gate; float* O;
    __device__ __forceinline__ void operator()(const f32x4 (&acc)[2][2][4][2], const Unit& u, int wr, int wc, int fr, int fq) const {
        const int row0 = u.pm * 256 + wr * 64 + fr, col0 = u.pn * 256 + wc * 32 + 4 * fq; const int b = (u.pm * 256) / SEQ;
        f32x4 gv[2][2];
#pragma unroll
        for (int bj = 0; bj < 2; ++bj)
#pragma unroll
            for (int n = 0; n < 2; ++n) gv[bj][n] = *(const f32x4*)(gate + b * 6 * D + col0 + bj * 128 + n * 16);
#pragma unroll
        for (int ai = 0; ai < 2; ++ai)
#pragma unroll
            for (int m = 0; m < 4; ++m) { const size_t off = (size_t)(row0 + ai * 128 + m * 16) * D + col0;
#pragma unroll
                for (int bj = 0; bj < 2; ++bj)
#pragma unroll
                    for (int n = 0; n < 2; ++n) { const f32x4 xv = *(const f32x4*)(x + off + bj * 128 + n * 16);
                        *(f32x4*)(O + off + bj * 128 + n * 16) = xv + gv[bj][n] * acc[ai][bj][m][n]; } }
    }
};
struct EpiGU {
    static constexpr bool PERM = true, WIDE = true;
    bf16* Hs;
    __device__ __forceinline__ void operator()(const f32x4 (&acc)[2][2][4][2], const Unit& u, int wr, int wc, int fr, int fq) const {
        const int j0 = u.pn * 128 + wc * 32 + 8 * fq;
#pragma unroll
        for (int ai = 0; ai < 2; ++ai)
#pragma unroll
            for (int m = 0; m < 4; ++m) { const int rl = ai * 128 + wr * 64 + m * 16 + fr;
                if (rl < u.nvalid) { unsigned w[2];
#pragma unroll
                    for (int bj = 0; bj < 2; ++bj) { const f32x4 g = acc[ai][bj][m][0], up = acc[ai][bj][m][1]; f32x4 h;
#pragma unroll
                        for (int j = 0; j < 4; ++j) h[j] = g[j] * sigmoidf_(g[j]) * up[j];
                        w[bj] = pk4_fp8(h.x, h.y, h.z, h.w); }
                    *(u32x2*)((unsigned char*)Hs + (size_t)(u.srow0 + rl) * DE + j0) = (u32x2){w[0], w[1]}; } }
    }
};
struct EpiDown {
    static constexpr bool PERM = true, WIDE = true;
    bf16* Y;
    __device__ __forceinline__ void operator()(const f32x4 (&acc)[2][2][4][2], const Unit& u, int wr, int wc, int fr, int fq) const {
        const int col0 = u.pn * 256 + wc * 64 + 16 * fq;
#pragma unroll
        for (int ai = 0; ai < 2; ++ai)
#pragma unroll
            for (int m = 0; m < 4; ++m) { const int rl = ai * 128 + wr * 64 + m * 16 + fr;
                if (rl < u.nvalid) { const f32x4 a0 = acc[ai][0][m][0], b0 = acc[ai][0][m][1], a1 = acc[ai][1][m][0], b1 = acc[ai][1][m][1];
                    *(u32x4*)((unsigned char*)Y + (size_t)(u.srow0 + rl) * D + col0) =
                        (u32x4){pk4_fp8(a0.x, a0.y, a0.z, a0.w), pk4_fp8(b0.x, b0.y, b0.z, b0.w), pk4_fp8(a1.x, a1.y, a1.z, a1.w), pk4_fp8(b1.x, b1.y, b1.z, b1.w)}; } }
    }
};

constexpr size_t WS_OG = 740 * MiB;
constexpr size_t WS_LSE = 764 * MiB;
struct AttnUnit { int tok0, i0, r, head; };
__device__ __forceinline__ AttnUnit attn_unit(int unit) {
    const int b = unit / 384, rem = unit % 384, g = rem >> 7, rem2 = rem & 127, hd = rem2 >> 5, q32 = rem2 & 31;
    const int nbg = 32 >> (2 * g), rho = q32 / nbg, blk = q32 % nbg;
    AttnUnit u; u.r = 1 << (2 * g); u.head = 4 * g + hd; u.tok0 = b * SEQ + rho; u.i0 = blk * 128; return u;
}
__device__ __forceinline__ void attn_issue_k(const bf16* P, LAS unsigned char* Kt, const AttnUnit& u, int w, int lane) {
#pragma unroll
    for (int i = 0; i < 8; ++i) { const int st = w + 8 * i, kb = st >> 2, ks = st & 3, sb = lane * 16, swz = sb ^ (((sb >> 9) & 1) << 5), row = swz >> 6, cch = (swz & 63) >> 1;
        int ksub = u.i0 + 16 * kb + row - 128; ksub = ksub < 0 ? 0 : ksub;
        const bf16* gp = P + (size_t)(u.tok0 + ksub * u.r) * INC + COL_K + u.head * HD + 32 * ks + cch;
        __builtin_amdgcn_global_load_lds((const unsigned*)gp, (LAS unsigned*)(Kt + w * 1024 + i * 8192), 16, 0, 0); }
}
__device__ __forceinline__ void attn_load_qv(const bf16* P, const AttnUnit& u, int w, int lane, bf16x8 (&Qf)[4], u32x4 (&va)[4], u32x4 (&vb)[4]) {
    const int fr = lane & 15, fq = lane >> 4;
    const int qtok = u.tok0 + (u.i0 + 16 * w + fr) * u.r;
#pragma unroll
    for (int ks = 0; ks < 4; ++ks) Qf[ks] = *(const bf16x8*)(P + (size_t)qtok * INC + COL_Q + u.head * HD + 32 * ks + 8 * fq);
    const int pair = lane & 15, key = 32 * w + 2 * pair;
    int ks0 = u.i0 + key - 128, ks1 = ks0 + 1; ks0 = ks0 < 0 ? 0 : ks0; ks1 = ks1 < 0 ? 0 : ks1;
    const bf16* v0p = P + (size_t)(u.tok0 + ks0 * u.r) * INC + COL_VA + u.head * HD; const bf16* v1p = P + (size_t)(u.tok0 + ks1 * u.r) * INC + COL_VA + u.head * HD;
#pragma unroll
    for (int it = 0; it < 4; ++it) { const int c = (lane >> 4) + 4 * it; va[it] = *(const u32x4*)(v0p + 8 * c); vb[it] = *(const u32x4*)(v1p + 8 * c); }
}
__device__ __forceinline__ void attn_write_v(LAS unsigned char* Vt, int w, int lane, const u32x4 (&va)[4], const u32x4 (&vb)[4]) {
    const int pair = lane & 15; const int slot = 8 * ((pair & 7) >> 1) + 4 * (pair >> 3) + 2 * (pair & 1); const bool odd = (lane >> 4) & 1;
#pragma unroll
    for (int it = 0; it < 4; ++it) { const int c = (lane >> 4) + 4 * it;
        const unsigned a4[4] = {va[it].x, va[it].y, va[it].z, va[it].w}, b4[4] = {vb[it].x, vb[it].y, vb[it].z, vb[it].w};
#pragma unroll
        for (int j = 0; j < 8; ++j) {
            const unsigned aw = a4[j >> 1], bw = b4[j >> 1];
            const unsigned e_lo = (aw & 0xffffu) | (bw << 16), e_hi = (aw >> 16) | (bw & 0xffff0000u);
            const unsigned ej = (j & 1) ? e_hi : e_lo, ejx = (j & 1) ? e_lo : e_hi;
            const unsigned word = odd ? ejx : ej; const int d = 8 * c + (odd ? (j ^ 1) : j);
            const int o2 = (d & 15) * 64 + slot * 2, addr = ((d >> 4) * 8 + w) * 1024 + (o2 ^ (((o2 >> 9) & 1) << 5));
            *(LAS unsigned*)(Vt + addr) = word; } }
}
__device__ __forceinline__ void p3_attn(Frame& F) {
    const bf16* P = (const bf16*)(F.ws + WS_PROJ); bf16* OG = (bf16*)(F.ws + WS_OG); float* LSE = (float*)(F.ws + WS_LSE);
    LAS unsigned char* Kt = F.lds; LAS unsigned char* Vt = F.lds + 65536;
    const int lane = F.lane, w = F.wave, fr = lane & 15, fq = lane >> 4;
    const int ob = fr * 64 + fq * 16, foff = ob ^ (((ob >> 9) & 1) << 5);
    int unit = F.vcu; if (unit >= 768) return;
    AttnUnit cu = attn_unit(unit);
    bf16x8 Qf[4], Qn[4]; u32x4 va[4], vb[4];
    attn_issue_k(P, Kt, cu, w, lane);
    attn_load_qv(P, cu, w, lane, Qf, va, vb);
    attn_write_v(Vt, w, lane, va, vb);
    for (;;) {
        const int nunit = unit + F.G; const bool more = nunit < 768; const AttnUnit nu = attn_unit(more ? nunit : unit);
        asm volatile("s_waitcnt vmcnt(0) lgkmcnt(0)" ::: "memory"); __syncthreads();
        attn_load_qv(P, nu, w, lane, Qn, va, vb);
        const int p0 = w >> 1;
        f32x4 sacc[10];
#pragma unroll
        for (int ff = 0; ff < 10; ++ff) { sacc[ff] = (f32x4){0.f, 0.f, 0.f, 0.f};
#pragma unroll
            for (int ks = 0; ks < 4; ++ks) { const bf16x8 Kf = *(const LAS bf16x8*)(Kt + ((2 * p0 + ff) * 4 + ks) * 1024 + foff);
                sacc[ff] = __builtin_amdgcn_mfma_f32_16x16x32_bf16(Kf, Qf[ks], sacc[ff], 0, 0, 0); } }
        asm volatile("s_waitcnt lgkmcnt(0)" ::: "memory"); __syncthreads();
        if (more) attn_issue_k(P, Kt, nu, w, lane);
        const int qi = 16 * w + fr; float mx = -1e30f;
#pragma unroll
        for (int ff = 0; ff < 10; ++ff)
#pragma unroll
            for (int rr = 0; rr < 4; ++rr) { const int kj = 16 * (2 * p0 + ff) + 4 * fq + rr; const bool valid = (kj >= qi) && (kj <= qi + 128) && (cu.i0 + kj >= 128);
                sacc[ff][rr] = valid ? sacc[ff][rr] : -1e30f; mx = fmaxf(mx, sacc[ff][rr]); }
        mx = fmaxf(mx, __shfl_xor(mx, 16)); mx = fmaxf(mx, __shfl_xor(mx, 32));
        float sm = 0.f;
#pragma unroll
        for (int ff = 0; ff < 10; ++ff)
#pragma unroll
            for (int rr = 0; rr < 4; ++rr) { const float pv = (sacc[ff][rr] > -1e29f) ? __expf(sacc[ff][rr] - mx) : 0.f; sacc[ff][rr] = pv; sm += pv; }
        sm += __shfl_xor(sm, 16); sm += __shfl_xor(sm, 32);
        f32x4 oacc[8];
#pragma unroll
        for (int db = 0; db < 8; ++db) oacc[db] = (f32x4){0.f, 0.f, 0.f, 0.f};
#pragma unroll
        for (int pp = 0; pp < 5; ++pp) { const u32x4 pw = pack8(sacc[2 * pp], sacc[2 * pp + 1]); const bf16x8 Pb = __builtin_bit_cast(bf16x8, pw);
#pragma unroll
            for (int db = 0; db < 8; ++db) { const bf16x8 Vf = *(const LAS bf16x8*)(Vt + (db * 8 + p0 + pp) * 1024 + foff);
                oacc[db] = __builtin_amdgcn_mfma_f32_16x16x32_bf16(Vf, Pb, oacc[db], 0, 0, 0); } }
        const float inv = 1.0f / sm;
        const int qtok = cu.tok0 + (cu.i0 + 16 * w + fr) * cu.r;
        bf16* orow = OG + (size_t)qtok * ATTW + cu.head * HD + 4 * fq;
#pragma unroll
        for (int db = 0; db < 8; ++db) { const f32x4 o = oacc[db] * inv; *(u32x2*)(orow + 16 * db) = (u32x2){pk2(o.x, o.y), pk2(o.z, o.w)}; }
        if (fq == 0) LSE[(size_t)qtok * 12 + cu.head] = mx + __logf(sm);
        if (!more) break;
        asm volatile("s_waitcnt lgkmcnt(0)" ::: "memory"); __syncthreads();
        attn_write_v(Vt, w, lane, va, vb);
#pragma unroll
        for (int ks = 0; ks < 4; ++ks) Qf[ks] = Qn[ks];
        cu = nu; unit = nunit;
    }
    __syncthreads();
}
__device__ __forceinline__ void p4_combine(Frame& F) {
    const bf16* OG = (const bf16*)(F.ws + WS_OG); const float* LSE = (const float*)(F.ws + WS_LSE); bf16* AO = (bf16*)(F.ws + WS_AO);
    for (int idx = F.vcu * NTHREADS + F.tid; idx < NT * 64; idx += F.G * NTHREADS) { const int t = idx >> 6, j = (idx >> 4) & 3, c8 = (idx & 15) * 8;
        const float l0 = LSE[t * 12 + j], l1 = LSE[t * 12 + 4 + j], l2 = LSE[t * 12 + 8 + j]; const float M = fmaxf(l0, fmaxf(l1, l2));
        float e[3] = {__expf(l0 - M), __expf(l1 - M), __expf(l2 - M)}; const float inv = 1.0f / (e[0] + e[1] + e[2]);
        float o[8] = {0.f, 0.f, 0.f, 0.f, 0.f, 0.f, 0.f, 0.f};
#pragma unroll
        for (int g = 0; g < 3; ++g) { const u32x4 v = *(const u32x4*)(OG + (size_t)t * ATTW + (4 * g + j) * HD + c8); const float wg = e[g] * inv;
            o[0] += wg * bflo(v.x); o[1] += wg * bfhi(v.x); o[2] += wg * bflo(v.y); o[3] += wg * bfhi(v.y); o[4] += wg * bflo(v.z); o[5] += wg * bfhi(v.z); o[6] += wg * bflo(v.w); o[7] += wg * bfhi(v.w); }
        *(u32x2*)((unsigned char*)AO + (size_t)t * AOW + j * HD + c8) = (u32x2){pk4_fp8(o[0], o[1], o[2], o[3]), pk4_fp8(o[4], o[5], o[6], o[7])};
    }
}
__device__ __forceinline__ void p3_conv(Frame& F) {
    const bf16* P = (const bf16*)(F.ws + WS_PROJ); bf16* CG = (bf16*)(F.ws + WS_CG);
    for (int idx = F.vcu * NTHREADS + F.tid; idx < NT * 128; idx += F.G * NTHREADS) { const int t = idx >> 7, c8 = (idx & 127) * 8, s = t & (SEQ - 1);
        const bf16* pr = P + (size_t)t * INC + c8;
        const u32x4 bv = *(const u32x4*)(pr + COL_B);
        float u[3][8];
#pragma unroll
        for (int d = 0; d < 3; ++d) {
            if (s >= d) { const u32x4 cv = *(const u32x4*)(pr - (size_t)d * INC + COL_C), vv = *(const u32x4*)(pr - (size_t)d * INC + COL_V);
                u[d][0] = bflo(cv.x) * bflo(vv.x); u[d][1] = bfhi(cv.x) * bfhi(vv.x); u[d][2] = bflo(cv.y) * bflo(vv.y); u[d][3] = bfhi(cv.y) * bfhi(vv.y);
                u[d][4] = bflo(cv.z) * bflo(vv.z); u[d][5] = bfhi(cv.z) * bfhi(vv.z); u[d][6] = bflo(cv.w) * bflo(vv.w); u[d][7] = bfhi(cv.w) * bfhi(vv.w); }
            else {
#pragma unroll
                for (int k = 0; k < 8; ++k) u[d][k] = 0.f; } }
        float bb[8] = {bflo(bv.x), bfhi(bv.x), bflo(bv.y), bfhi(bv.y), bflo(bv.z), bfhi(bv.z), bflo(bv.w), bfhi(bv.w)};
        float o[8];
#pragma unroll
        for (int k = 0; k < 8; ++k) { const float w2 = F.conv_w[2 * CONVW + c8 + k], w1 = F.conv_w[CONVW + c8 + k], w0 = F.conv_w[c8 + k];
            o[k] = bb[k] * (w2 * u[0][k] + w1 * u[1][k] + w0 * u[2][k]); }
        *(u32x2*)((unsigned char*)CG + (size_t)t * CONVW + c8) = (u32x2){pk4_fp8(o[0], o[1], o[2], o[3]), pk4_fp8(o[4], o[5], o[6], o[7])};
    }
}

__device__ __forceinline__ void p6_route(Frame& F, bool dry) {
    const int gw = F.vcu * NWAVES + F.wave, NGW = F.G * NWAVES, lane = F.lane, w = F.wave, fr = lane & 15, fq = lane >> 4;
    const float* mod = (const float*)(F.ws + WS_MOD); const float* X1 = (const float*)(F.ws + WS_X1); bf16* H2 = (bf16*)(F.ws + WS_H2);
    const bf16* wrh = (const bf16*)(F.ws + WS_WRH); const bf16* wrl = (const bf16*)(F.ws + WS_WRL);
    int* tkid = (int*)(F.ws + WS_TKID); float* tkw = (float*)(F.ws + WS_TKW); int* tkpos = (int*)(F.ws + WS_TKPOS); int* list = (int*)(F.ws + WS_LIST);
    int* cnt = (int*)(F.ws + WS_CTL) + CW_CNT;
    constexpr int HP = 520;
    constexpr int TPW = 2;
    LAS bf16* Hh = (LAS bf16*)(F.lds); LAS bf16* Hl = Hh + 16 * HP;
    LAS float* lg = (LAS float*)(F.lds + 2 * 16 * HP * 2);
    LAS int* hist = (LAS int*)(F.lds + 2 * 16 * HP * 2 + 2 * 16 * 64 * 4); LAS int* basep = hist + 64;
    const float rbias = F.router_bias[lane];
    for (int t0 = gw; t0 < NT; t0 += TPW * NGW) {
        if (F.tid < 64) hist[F.tid] = 0;
        f32x4 yv[TPW][8];
#pragma unroll
        for (int k = 0; k < TPW; ++k) { const int t = t0 + k * NGW; const int tc = t < NT ? t : NT - 1; const int b = tc / SEQ;
            const f32x4* xr = (const f32x4*)(X1 + (size_t)tc * D) + lane; float ss = 0.f;
#pragma unroll
            for (int j = 0; j < 8; ++j) { yv[k][j] = __builtin_nontemporal_load(xr + 64 * j); ss += (yv[k][j].x * yv[k][j].x + yv[k][j].y * yv[k][j].y) + (yv[k][j].z * yv[k][j].z + yv[k][j].w * yv[k][j].w); }
            const float rstd = rsqrtf(wave_sum(ss) * (1.f / D) + EPS);
            unsigned* o = (unsigned*)((unsigned char*)H2 + (size_t)tc * D) + lane;
#pragma unroll
            for (int j = 0; j < 8; ++j) { const int col = 4 * lane + 256 * j;
                const f32x4 g = *(const f32x4*)(F.norm_ffn_g + col), sh = *(const f32x4*)(mod + b * 6 * D + 3 * D + col), sc = *(const f32x4*)(mod + b * 6 * D + 4 * D + col);
                yv[k][j] = yv[k][j] * rstd * g * (sc + 1.0f) + sh;
                if (t < NT) o[64 * j] = pk4_fp8(yv[k][j].x, yv[k][j].y, yv[k][j].z, yv[k][j].w);
 } }
        f32x4 acc = {0.f, 0.f, 0.f, 0.f};
        const int ni = w & 3, kh = w >> 2;
        const bf16* bh = wrh + (size_t)(16 * ni + fr) * D + 8 * fq; const bf16* bl = wrl + (size_t)(16 * ni + fr) * D + 8 * fq;
        bf16x8 wh[8], wl[8];
#pragma unroll
        for (int q = 0; q < 8; ++q) { wh[q] = *(const bf16x8*)(bh + 32 * (8 * kh + q)); wl[q] = *(const bf16x8*)(bl + 32 * (8 * kh + q)); }
#pragma unroll
        for (int c = 0; c < 4; ++c) {
            __syncthreads();
#pragma unroll
            for (int k = 0; k < TPW; ++k)
#pragma unroll
                for (int jj = 0; jj < 2; ++jj) { const f32x4 y = yv[k][2 * c + jj];
                    const unsigned h0 = f2bf(y.x), h1 = f2bf(y.y), h2_ = f2bf(y.z), h3 = f2bf(y.w);
                    const int off = (8 * k + w) * HP + 4 * lane + 256 * jj;
                    *(LAS u32x2*)(Hh + off) = (u32x2){h0 | (h1 << 16), h2_ | (h3 << 16)};
                    *(LAS u32x2*)(Hl + off) = (u32x2){pk2(y.x - __builtin_bit_cast(float, h0 << 16), y.y - __builtin_bit_cast(float, h1 << 16)), pk2(y.z - __builtin_bit_cast(float, h2_ << 16), y.w - __builtin_bit_cast(float, h3 << 16))}; }
            __syncthreads();
            {
#pragma unroll
                for (int q = 0; q < 8; ++q) { const int ks = 8 * kh + q;
                    const bf16x8 ah = *(const LAS bf16x8*)(Hh + fr * HP + 32 * ks + 8 * fq), al = *(const LAS bf16x8*)(Hl + fr * HP + 32 * ks + 8 * fq);
                    acc = __builtin_amdgcn_mfma_f32_16x16x32_bf16(ah, wh[q], acc, 0, 0, 0);
                    acc = __builtin_amdgcn_mfma_f32_16x16x32_bf16(ah, wl[q], acc, 0, 0, 0);
                    acc = __builtin_amdgcn_mfma_f32_16x16x32_bf16(al, wh[q], acc, 0, 0, 0); } }
            if (c < 3) {
#pragma unroll
                for (int q = 0; q < 8; ++q) { wh[q] = *(const bf16x8*)(bh + 512 * (c + 1) + 32 * (8 * kh + q)); wl[q] = *(const bf16x8*)(bl + 512 * (c + 1) + 32 * (8 * kh + q)); } }
        }
#pragma unroll
        for (int r = 0; r < 4; ++r) lg[kh * 1024 + (4 * fq + r) * 64 + 16 * ni + fr] = acc[r];
        __syncthreads();
        int loc[TPW], rk[TPW]; bool ch[TPW];
#pragma unroll
        for (int k = 0; k < TPW; ++k) { const int t = t0 + k * NGW; ch[k] = false; loc[k] = 0; rk[k] = 0;
            if (t < NT) {
                const float logit = lg[(8 * k + w) * 64 + lane] + lg[1024 + (8 * k + w) * 64 + lane];
                const float scv = sigmoidf_(logit), sel = scv + rbias;
                int rin = 0;
#pragma unroll
                for (int d = 1; d < 8; ++d) { const float ov = __shfl_xor(sel, d); const int oj = lane ^ d; rin += ((ov > sel) || (ov == sel && oj < lane)) ? 1 : 0; }
                float gs = rin < 2 ? sel : 0.f; gs += __shfl_xor(gs, 1); gs += __shfl_xor(gs, 2); gs += __shfl_xor(gs, 4);
                const int myg = lane >> 3; int grank = 0;
#pragma unroll
                for (int d = 1; d < 8; ++d) { const float ov = __shfl_xor(gs, d << 3); const int og = myg ^ d; grank += ((ov > gs) || (ov == gs && og < myg)) ? 1 : 0; }
                const float mv = (grank < 4) ? sel : -1e30f;
                LAS float* mvt = (LAS float*)(hist + 128) + (w * TPW + k) * 64;
                mvt[lane] = mv; LDS_WAIT(); __builtin_amdgcn_wave_barrier();
                int rank = 0;
#pragma unroll
                for (int d4 = 0; d4 < 16; ++d4) { const f32x4 o4 = *(const LAS f32x4*)(mvt + 4 * d4);
#pragma unroll
                    for (int i = 0; i < 4; ++i) { const int oj = 4 * d4 + i; const float ov = o4[i]; rank += ((ov > mv) || (ov == mv && oj < lane)) ? 1 : 0; } }
                const bool chosen = rank < TOPK;
                const float wsum = wave_sum(chosen ? scv : 0.f);
                ch[k] = chosen && !dry; rk[k] = rank;
                if (ch[k]) { loc[k] = __hip_atomic_fetch_add(hist + lane, 1, __ATOMIC_RELAXED, __HIP_MEMORY_SCOPE_WORKGROUP); tkid[t * 8 + rank] = lane; tkw[t * 8 + rank] = scv / wsum * 2.5f; }
                if (lane == 0 && !dry) list[NE * LISTCAP + t] = t;
            } }
        __syncthreads();
        if (F.tid < 64) { const int c = hist[F.tid]; basep[F.tid] = (c > 0) ? atomicAdd(cnt + F.tid * CNT_STRIDE, c) : 0; }
        __syncthreads();
#pragma unroll
        for (int k = 0; k < TPW; ++k) { const int t = t0 + k * NGW;
            if (ch[k]) { const int pos = basep[lane] + loc[k]; list[lane * LISTCAP + pos] = t; tkpos[t * 8 + rk[k]] = pos; } }
        __syncthreads();
    }
}
__device__ __forceinline__ int moe_tables(Frame& F, LAS int*& tp, LAS int*& cn, LAS int*& of) {
    LAS int* base = (LAS int*)(F.lds + 131072 + 8192);
    cn = base; of = base + 80; tp = base + 160;
    const int* cnt = (const int*)(F.ws + WS_CTL) + CW_CNT;
    if (F.wave == 0) {
        const int lane = F.lane; const int c = __hip_atomic_load(cnt + lane * CNT_STRIDE, __ATOMIC_RELAXED, __HIP_MEMORY_SCOPE_AGENT); const int tl = (c + 255) >> 8;
        int so = c, st = tl;
#pragma unroll
        for (int o = 1; o < 64; o <<= 1) { const int a = __shfl_up(so, o), b2 = __shfl_up(st, o); if (lane >= o) { so += a; st += b2; } }
        cn[lane] = c; of[lane] = so - c; tp[lane] = st - tl;
        if (lane == 63) { cn[NE] = NT; of[NE] = so; tp[NE] = st; tp[NEX] = st + NT / 256; }
    }
    __syncthreads();
    return tp[NEX];
}

__device__ __forceinline__ f32x2 fp8x2_lo(unsigned w) { return __builtin_amdgcn_cvt_pk_f32_fp8((int)w, false); }
__device__ __forceinline__ f32x2 fp8x2_hi(unsigned w) { return __builtin_amdgcn_cvt_pk_f32_fp8((int)w, true); }
__device__ __forceinline__ void p9_final(Frame& F, const LAS int* of) {
    const int gw = F.vcu * NWAVES + F.wave, NGW = F.G * NWAVES, lane = F.lane;
    const float* mod = (const float*)(F.ws + WS_MOD); const float* X1 = (const float*)(F.ws + WS_X1); const unsigned char* Y = (const unsigned char*)(F.ws + WS_Y);
    const int* tkid = (const int*)(F.ws + WS_TKID); const float* tkw = (const float*)(F.ws + WS_TKW); const int* tkpos = (const int*)(F.ws + WS_TKPOS);
    for (int t0 = gw; t0 < NT; t0 += 2 * NGW) {
        int rowv[2]; float wv[2]; int tt[2];
#pragma unroll
        for (int k = 0; k < 2; ++k) { const int t = (t0 + k * NGW < NT) ? t0 + k * NGW : t0; tt[k] = t;
            rowv[k] = of[NE] + t; wv[k] = 1.0f;
            if (lane < TOPK) { const int e = tkid[t * 8 + lane]; rowv[k] = of[e] + tkpos[t * 8 + lane]; wv[k] = tkw[t * 8 + lane]; } }
        u32x4 yv[2][9][2];
#pragma unroll
        for (int k = 0; k < 2; ++k)
#pragma unroll
            for (int q = 0; q < 9; ++q) { const int row = __builtin_amdgcn_readlane(rowv[k], q); const u32x4* yr = (const u32x4*)(Y + (size_t)row * D) + lane;
                yv[k][q][0] = __builtin_nontemporal_load(yr); yv[k][q][1] = __builtin_nontemporal_load(yr + 64); }
#pragma unroll
        for (int k = 0; k < 2; ++k) { const int t = tt[k]; const int b = t / SEQ;
            f32x4 m[8];
#pragma unroll
            for (int j = 0; j < 8; ++j) m[j] = (f32x4){0.f, 0.f, 0.f, 0.f};
#pragma unroll
            for (int q = 0; q < 9; ++q) { const float wk = __builtin_bit_cast(float, __builtin_amdgcn_readlane(__builtin_bit_cast(int, wv[k]), q));
#pragma unroll
                for (int j = 0; j < 2; ++j) { const unsigned ww[4] = {yv[k][q][j].x, yv[k][q][j].y, yv[k][q][j].z, yv[k][q][j].w};
#pragma unroll
                    for (int c = 0; c < 4; ++c) { const f32x2 lo = fp8x2_lo(ww[c]), hi = fp8x2_hi(ww[c]); m[4 * j + c] += (f32x4){lo.x, lo.y, hi.x, hi.y} * wk; } } }
            float ss = 0.f;
#pragma unroll
            for (int j = 0; j < 2; ++j)
#pragma unroll
                for (int c = 0; c < 4; ++c) { const int col = 16 * lane + 1024 * j + 4 * c; const f32x4 g2 = *(const f32x4*)(mod + b * 6 * D + 5 * D + col);
                    f32x4& v = m[4 * j + c]; v = *(const f32x4*)(X1 + (size_t)t * D + col) + g2 * v; ss += (v.x * v.x + v.y * v.y) + (v.z * v.z + v.w * v.w); }
            const float rstd = rsqrtf(wave_sum(ss) * (1.f / D) + EPS);
            if (k == 0 || t0 + NGW < NT) {
#pragma unroll
                for (int j = 0; j < 2; ++j)
#pragma unroll
                    for (int c = 0; c < 4; ++c) { const int col = 16 * lane + 1024 * j + 4 * c; *(f32x4*)(F.out + (size_t)t * D + col) = m[4 * j + c] * rstd * *(const f32x4*)(F.norm_final_g + col); } }
        }
    }
}

#define GEMM_PHASE(S, E) gemm_phase<decltype(E), decltype(S), true, false>(F.lds, S, E)
#define GEMM_PHASE8(S, E) gemm_phase<decltype(E), decltype(S), true, true>(F.lds, S, E)
constexpr int N_CONV_CU = 108;
struct Args { const void* in[21]; float* out; unsigned char* ws; int ph_lo, ph_hi; };
constexpr int N_PHASES = 10;

__global__ void __launch_bounds__(NTHREADS, 2) fwd(Args args) {
    extern __shared__ __attribute__((aligned(16))) unsigned char lds[];
    Frame F;
    F.lds = (LAS unsigned char*)lds;
    F.tid = threadIdx.x; F.lane = F.tid & 63; F.wave = __builtin_amdgcn_readfirstlane(F.tid >> 6);
    F.G = gridDim.x; { const int bx = blockIdx.x; F.vcu = (F.G % 8 == 0) ? (bx % 8) * (F.G / 8) + bx / 8 : bx; }
    F.ws = args.ws; F.out = args.out;
    F.x = (const float*)args.in[0]; F.c = (const float*)args.in[1]; F.positions = (const int*)args.in[2]; F.norm_mix_g = (const float*)args.in[3];
    F.w_ada = (const float*)args.in[4]; F.b_ada = (const float*)args.in[5]; F.w_in = (const float*)args.in[6]; F.conv_w = (const float*)args.in[7];
    F.w_conv_out = (const float*)args.in[8]; F.w_attn_out = (const float*)args.in[9]; F.w_o = (const float*)args.in[10]; F.norm_ffn_g = (const float*)args.in[11];
    F.w_router = (const float*)args.in[12]; F.router_bias = (const float*)args.in[13]; F.w_exp_gate = (const float*)args.in[14]; F.w_exp_up = (const float*)args.in[15];
    F.w_exp_down = (const float*)args.in[16]; F.w_sh_gate = (const float*)args.in[17]; F.w_sh_up = (const float*)args.in[18]; F.w_sh_down = (const float*)args.in[19];
    F.norm_final_g = (const float*)args.in[20];
    const int lo = args.ph_lo, hi = args.ph_hi;
#define IN(k) (lo <= (k) && (k) < hi)
#define SEAM(k) do { if (IN(k) && IN((k) + 1)) xcd_barrier(bar); } while (0)
    if (F.tid == 0) { ((LAS unsigned*)(F.lds + LDS_BARW))[0] = 0u; ((LAS unsigned*)(F.lds + LDS_BARW))[1] = 0u; }
    __syncthreads();
    XcdBarrier bar; bar.bar = (unsigned*)(args.ws + WS_CTL) + CW_BAR; bar.x = 0; bar.st = nullptr;
    if (hi - lo > 1) bar = xcd_barrier_post((unsigned*)(args.ws + WS_CTL) + CW_BAR, (volatile LAS unsigned*)(F.lds + LDS_BARW));
    unsigned char* ws = F.ws;
    const float* mod = (const float*)(ws + WS_MOD);

    if (IN(0)) { p0_prologue(F); }
    SEAM(0);
    if (IN(1)) { p1_hnorm(F); }
    SEAM(1);
    if (IN(2)) {
        const int ngemm = (F.G > N_CONV_CU + 8) ? F.G - N_CONV_CU : F.G;
        if ((int)blockIdx.x < ngemm) {
            SchedPlain S; S.init((const bf16*)(ws + WS_H), (const bf16*)(ws + WS_WIN), NT, INC, D / 2, ngemm, (int)blockIdx.x); S.gs = 4;
            EpiProj E{(bf16*)(ws + WS_PROJ), (const f32x2*)(ws + WS_ROPE)};
            GEMM_PHASE8(S, E);
        }
        if (ngemm == F.G || (int)blockIdx.x >= ngemm) {
            const int nconv = (ngemm == F.G) ? F.G : F.G - ngemm, ci = (ngemm == F.G) ? (int)blockIdx.x : (int)blockIdx.x - ngemm;
            constexpr int NS = P0_NSTEPS - P0_S_MIX;
            convert_experts(F, (int)(((long)ci * NS) / nconv), (int)(((long)(ci + 1) * NS) / nconv), F.lds + F.wave * 16384);
        }
    }
    SEAM(2);
    if (IN(3)) { p3_attn(F); p3_conv(F); xcd_barrier(bar); p4_combine(F); }
    SEAM(3);
    if (IN(4)) {
        { SchedPlain S; S.init((const bf16*)(ws + WS_CG), (const bf16*)(ws + WS_WC), NT, D, CONVW / 2, F.G, (int)blockIdx.x);
          EpiGate<false> E{(const bf16*)(ws + WS_PROJ), COL_GC, nullptr, (bf16*)(ws + WS_T1)}; GEMM_PHASE8(S, E); }
        { SchedPlain S; S.init((const bf16*)(ws + WS_AO), (const bf16*)(ws + WS_WA), NT, D, AOW / 2, F.G, (int)blockIdx.x);
          EpiGate<true> E{(const bf16*)(ws + WS_PROJ), COL_GA, (const bf16*)(ws + WS_T1), (bf16*)(ws + WS_MG)}; GEMM_PHASE8(S, E); }
    }
    SEAM(4);
    if (IN(5)) {
        SchedPlain S; S.init((const bf16*)(ws + WS_MG), (const bf16*)(ws + WS_WO), NT, D, D / 2, F.G, (int)blockIdx.x);
        EpiX1 E{F.x, mod + 2 * D, (float*)(ws + WS_X1)}; GEMM_PHASE8(S, E);
    }
    SEAM(5);
    if (IN(6)) { p6_route(F, false); }
    SEAM(6);
    if (IN(7)) {
        LAS int *tp, *cn, *of; const int ntiles = moe_tables(F, tp, cn, of);
        SchedMoE S; S.A = ws + WS_H2; S.Bt = ws + WS_WGU; S.list = (const int*)(ws + WS_LIST); S.KB = D; S.NTN = 4; S.G = F.G; S.c = (int)blockIdx.x;
        S.nwg = ntiles * 4; S.bstride = (size_t)1024 * D; S.gather = true; S.tp = tp; S.cnt = cn; S.off = of;
        {
            LAS int* llw = (LAS int*)(F.lds + 131072); Unit u;
            for (int i = 0; i < 8 && S.next(i, u); ++i) if (F.tid < 256) llw[i * 256 + F.tid] = S.list[u.e * LISTCAP + 256 * u.pm + (F.tid < u.nvalid ? F.tid : u.nvalid - 1)];
            S.ll = llw; __syncthreads(); }
        EpiGU E{(bf16*)(ws + WS_HS)}; GEMM_PHASE8(S, E);
    }
    SEAM(7);
    if (IN(8)) {
        LAS int *tp, *cn, *of; const int ntiles = moe_tables(F, tp, cn, of);
        SchedMoE S; S.A = ws + WS_HS; S.Bt = ws + WS_WD; S.list = nullptr; S.KB = DE; S.NTN = 8; S.G = F.G; S.c = (int)blockIdx.x;
        S.nwg = ntiles * 8; S.bstride = (size_t)D * DE; S.gather = false; S.ll = nullptr; S.tp = tp; S.cnt = cn; S.off = of;
        EpiDown E{(bf16*)(ws + WS_Y)}; GEMM_PHASE8(S, E);
    }
    SEAM(8);
    if (IN(9)) { LAS int *tp, *cn, *of; (void)moe_tables(F, tp, cn, of); p9_final(F, of); }
#undef IN
#undef SEAM
}

extern "C" void kernel_launch(void* const* d_in, const int* in_sizes, int n_in, void* d_out, int out_size, void* d_ws, size_t ws_size, hipStream_t stream) {
    static int grid = 0;
    if (grid == 0) {
        if (n_in != 21 || out_size != NT * D || ws_size < WS_END) { fprintf(stderr, "kernel_launch: unexpected shapes (n_in %d out %d ws %zu)\n", n_in, out_size, ws_size); grid = -1; return; }
        int dev = 0, cus = 0;
        if (hipGetDevice(&dev) != hipSuccess || hipDeviceGetAttribute(&cus, hipDeviceAttributeMultiprocessorCount, dev) != hipSuccess) { grid = -1; return; }
        if (hipFuncSetAttribute((const void*)fwd, hipFuncAttributeMaxDynamicSharedMemorySize, LDS_BYTES) != hipSuccess) { fprintf(stderr, "kernel_launch: hipFuncSetAttribute failed\n"); grid = -1; return; }
        (void)hipGetLastError();
        grid = cus;
    }
    if (grid < 0) return;
    (void)hipMemsetAsync((char*)d_ws + WS_CTL, 0, CTL_ZERO_BYTES, stream);
    Args a{};
    for (int i = 0; i < 21; ++i) a.in[i] = d_in[i];
    a.out = (float*)d_out; a.ws = (unsigned char*)d_ws;
#if defined(MK_PER_PHASE)
    for (int ph = 0; ph < N_PHASES; ++ph) { a.ph_lo = ph; a.ph_hi = ph + 1; hipLaunchKernelGGL(fwd, dim3(grid), dim3(NTHREADS), LDS_BYTES, stream, a); }
#else
    a.ph_lo = 0; a.ph_hi = N_PHASES; hipLaunchKernelGGL(fwd, dim3(grid), dim3(NTHREADS), LDS_BYTES, stream, a);
#endif
}
```

```cpp
#include <hip/hip_runtime.h>
#include <cstdio>
#include <cstdint>

#define GAS __attribute__((address_space(1)))
#define LAS __attribute__((address_space(3)))
typedef unsigned short bf16;
typedef short bf16x8 __attribute__((ext_vector_type(8)));
typedef float f32x4 __attribute__((ext_vector_type(4)));
typedef float f32x2 __attribute__((ext_vector_type(2)));
typedef unsigned u32x4 __attribute__((ext_vector_type(4)));
typedef unsigned u32x2 __attribute__((ext_vector_type(2)));

constexpr int NB = 2, SEQ = 4096, NT = NB * SEQ, D = 2048;
constexpr int CONVW = 1024, ATTW = 1536, HD = 128, AOW = 512;
constexpr int INC = 3 * CONVW + 3 * ATTW + 2 * D;
constexpr int COL_B = 0, COL_C = 1024, COL_V = 2048, COL_Q = 3072, COL_K = 4608, COL_VA = 6144, COL_GC = 7680, COL_GA = 9728;
constexpr int NE = 64, NEX = 65  , TOPK = 8, DE = 512;
constexpr float EPS = 1e-6f;
constexpr int NWAVES = 8, NTHREADS = 512;
constexpr int LISTCAP = 8192;

constexpr size_t MiB = 1u << 20;
constexpr size_t WS_CTL = 0, CTL_ZERO_BYTES = 1 * MiB;
constexpr size_t WS_MOD = 1 * MiB;
constexpr size_t WS_WRH = 1 * MiB + 128 * 1024, WS_WRL = 1 * MiB + 384 * 1024;
constexpr size_t WS_ROPE = 2 * MiB;
constexpr size_t WS_TKID = 6 * MiB;
constexpr size_t WS_TKW = WS_TKID + 256 * 1024;
constexpr size_t WS_TKPOS = WS_TKW + 256 * 1024;
constexpr size_t WS_LIST = 7 * MiB;
constexpr size_t WS_WC = 10 * MiB;
constexpr size_t WS_WA = 14 * MiB;
constexpr size_t WS_WO = 16 * MiB;
constexpr size_t WS_WIN = 24 * MiB;
constexpr size_t WS_WGU = 70 * MiB;
constexpr size_t WS_WD = 330 * MiB;
constexpr size_t WS_X1 = 460 * MiB;
constexpr size_t WS_PROJ = 524 * MiB;
constexpr size_t WS_H2 = 524 * MiB;
constexpr size_t WS_HS = 556 * MiB;
constexpr size_t WS_Y = 708 * MiB;
constexpr size_t WS_H = 708 * MiB;
constexpr size_t WS_CG = 766 * MiB;
constexpr size_t WS_AO = 782 * MiB;
constexpr size_t WS_T1 = 790 * MiB;
constexpr size_t WS_MG = 822 * MiB;
constexpr size_t WS_END = 998 * MiB;
constexpr int CW_CNT = 16384, CNT_STRIDE = 64;
constexpr int CW_BAR = 4096;
constexpr int LDS_BARW = 147456 - 16;

constexpr int LDS_BYTES = 147456;

__device__ __forceinline__ unsigned f2bf(float f) { unsigned u = __builtin_bit_cast(unsigned, f); return (u + 0x7fffu + ((u >> 16) & 1u)) >> 16; }
__device__ __forceinline__ unsigned pk2(float lo, float hi) { unsigned r; asm("v_cvt_pk_bf16_f32 %0, %1, %2" : "=v"(r) : "v"(lo), "v"(hi)); return r; }
__device__ __forceinline__ float bflo(unsigned w) { return __builtin_bit_cast(float, w << 16); }
__device__ __forceinline__ float bfhi(unsigned w) { return __builtin_bit_cast(float, w & 0xffff0000u); }
__device__ __forceinline__ float bf1(bf16 v) { return __builtin_bit_cast(float, ((unsigned)v) << 16); }
__device__ __forceinline__ float wave_sum(float v) {
#pragma unroll
    for (int o = 1; o < 64; o <<= 1) v += __shfl_xor(v, o);
    return v;
}
__device__ __forceinline__ float wave_max(float v) {
#pragma unroll
    for (int o = 1; o < 64; o <<= 1) v = fmaxf(v, __shfl_xor(v, o));
    return v;
}
__device__ __forceinline__ float sigmoidf_(float v) { return 1.0f / (1.0f + __expf(-v)); }
__host__ __device__ __forceinline__ int perm32(int rho) { const int n = rho >> 4, i = rho & 15; return 8 * (i >> 2) + 4 * n + (i & 3); }
#define LDS_WAIT() asm volatile("s_waitcnt lgkmcnt(0)" ::: "memory")
typedef int i32x8 __attribute__((ext_vector_type(8)));
__device__ __forceinline__ unsigned pk4_fp8(float a, float b, float c, float d) { int w = __builtin_amdgcn_cvt_pk_fp8_f32(a, b, 0, false); w = __builtin_amdgcn_cvt_pk_fp8_f32(c, d, w, true); return (unsigned)w; }
constexpr float W8_SCALE = 32.0f;
constexpr int SCALE_W8 = 0x7a7a7a7a, SCALE_ONE = 0x7f7f7f7f;


#define XB_TMO      128
#define XB_XCNT(j)  (256  + 64 * (j))
#define XB_XSUB(j)  (1280 + 64 * (j))
#define XB_XGEN(j)  (2304 + 64 * (j))
#define XB_TOP      3328
#define XB_TOPGEN   3392
#define XCD_BAR_WORDS 3456
#define XB_SPIN_CAP (1u << 18)

__device__ __forceinline__ unsigned xb_ld(unsigned* p)              { return __hip_atomic_load(p, __ATOMIC_RELAXED, __HIP_MEMORY_SCOPE_AGENT); }
__device__ __forceinline__ unsigned xb_add(unsigned* p, unsigned v) { return __hip_atomic_fetch_add(p, v, __ATOMIC_RELAXED, __HIP_MEMORY_SCOPE_AGENT); }
__device__ __forceinline__ unsigned xb_xcc_id() { return (unsigned)__builtin_amdgcn_s_getreg((3 << 11) | 20) & 0xFu; }
#define XB_SPIN(cond, bar) do { unsigned _sp = 0; while (cond) { __builtin_amdgcn_s_sleep(1); \
    if ((++_sp & 255u) == 0u) { if (xb_ld(&(bar)[XB_TMO])) break; if (_sp > XB_SPIN_CAP) { atomicAdd(&(bar)[XB_TMO], 1u); break; } } } } while (0)

struct XcdBarrier {
    unsigned* bar; unsigned x;
    volatile LAS unsigned* st;
};
__device__ __forceinline__ XcdBarrier xcd_barrier_post(unsigned* bar, volatile LAS unsigned* st) {
    XcdBarrier b; b.bar = bar; b.x = xb_xcc_id(); b.st = st;
    if (threadIdx.x == 0) (void)xb_add(&bar[XB_XCNT(b.x)], 1u);
    return b;
}
__device__ __forceinline__ void xcd_barrier_complete(unsigned* bar, unsigned x, unsigned& nloc, unsigned& nx) {
    const unsigned G = gridDim.x * gridDim.y * gridDim.z;
    unsigned sum, cnt, mine, sp = 0u;
    for (;;) {
        sum = 0u; cnt = 0u; mine = 0u;
#pragma unroll
        for (unsigned j = 0; j < 16; ++j) { const unsigned c = xb_ld(&bar[XB_XCNT(j)]); sum += c; cnt += (c > 0u) ? 1u : 0u; mine = (j == x) ? c : mine; }
        if (sum == G) break;
        __builtin_amdgcn_s_sleep(1);
        if ((++sp & 255u) == 0u) { if (xb_ld(&bar[XB_TMO])) break; if (sp > XB_SPIN_CAP) { atomicAdd(&bar[XB_TMO], 1u); break; } }
    }
    nloc = mine > 0u ? mine : 1u; nx = cnt > 0u ? cnt : 1u;
}
__device__ __forceinline__ void xcd_barrier(const XcdBarrier& b) {
    asm volatile("s_waitcnt vmcnt(0)" ::: "memory");
    __syncthreads();
    if (threadIdx.x == 0) {
        unsigned* bar = b.bar;
        __builtin_amdgcn_s_waitcnt(0);
        unsigned nloc = b.st[0], nx = b.st[1];
        if (nloc == 0u) { xcd_barrier_complete(bar, b.x, nloc, nx); b.st[0] = nloc; b.st[1] = nx; }
        const unsigned old = xb_add(&bar[XB_XSUB(b.x)], 1u);
        const unsigned gen = old / nloc;
        if (old + 1u == (gen + 1u) * nloc) {
            __builtin_amdgcn_fence(__ATOMIC_RELEASE, "agent");
            asm volatile("s_waitcnt vmcnt(0)" ::: "memory");
            const unsigned og = xb_add(&bar[XB_TOP], 1u);
            const unsigned tg = og / nx;
            if (og + 1u == (tg + 1u) * nx) xb_add(&bar[XB_TOPGEN], 1u);
            else XB_SPIN(xb_ld(&bar[XB_TOPGEN]) == tg, bar);
            __builtin_amdgcn_fence(__ATOMIC_ACQUIRE, "agent");
            xb_add(&bar[XB_XGEN(b.x)], 1u);
            asm volatile("s_waitcnt vmcnt(0)" ::: "memory");
        } else {
            XB_SPIN(xb_ld(&bar[XB_XGEN(b.x)]) == gen, bar);
            __builtin_amdgcn_fence(__ATOMIC_ACQUIRE, "agent");
            asm volatile("s_waitcnt vmcnt(0)" ::: "memory");
        }
    }
    __syncthreads();
}

struct Frame {
    LAS unsigned char* lds;
    int tid, lane, wave, vcu, G;
    unsigned char* ws;
    const float *x, *c, *norm_mix_g, *w_ada, *b_ada, *w_in, *conv_w, *w_conv_out, *w_attn_out, *w_o, *norm_ffn_g, *w_router, *router_bias,
        *w_exp_gate, *w_exp_up, *w_exp_down, *w_sh_gate, *w_sh_up, *w_sh_down, *norm_final_g;
    const int* positions;
    float* out;
};

struct TItem { const float* src; bf16* dst; int N, K, row_off, ilv, dd0, fp8; };
__device__ __forceinline__ TItem titem_make(const float* W, int K, int N, bf16* WT, int item, int mode  , int row_off2) {
    const int nblk = N / 32, kb = item / nblk, nb = item % nblk, k0 = 64 * kb, n0 = 32 * nb;
    TItem t; t.src = W + (size_t)k0 * N + n0; t.dst = WT + k0; t.N = N; t.K = K; t.row_off = n0; t.ilv = 0; t.dd0 = 0; t.fp8 = 0;
    if (mode == 1) { t.row_off = row_off2; t.ilv = 1; t.dd0 = n0; }
    else if (mode == 2 && n0 >= COL_Q && n0 < COL_VA) { const int hn = (n0 - COL_Q) & 127, hb = n0 - hn; t.row_off = hb + ((hn >= 64) ? 4 : 0); t.ilv = 1; t.dd0 = hn & 63; }
    return t;
}
constexpr int P0_S_IN = 46 * 32, P0_S_CO = 8 * 16, P0_S_AO = 8 * 8, P0_S_WO = 8 * 32, P0_S_EX = 2 * 32 + 2 * 32 + 8 * 8, P0_NSTEPS = P0_S_IN + P0_S_CO + P0_S_AO + P0_S_WO + 65 * P0_S_EX;
__device__ __forceinline__ TItem titem_step(Frame& F, int s, int w) {
    if (s < P0_S_IN) { const int sc = s >> 5, kb = s & 31; TItem t = titem_make(F.w_in, D, INC, (bf16*)(F.ws + WS_WIN), kb * (INC / 32) + 8 * sc + w, 2, 0);
        t.fp8 = 1; t.dst = (bf16*)(F.ws + WS_WIN + 64 * kb); return t; } s -= P0_S_IN;
    if (s < P0_S_CO) { const int sc = s >> 4, kb = s & 15; TItem t = titem_make(F.w_conv_out, CONVW, D, (bf16*)(F.ws + WS_WC), kb * 64 + 8 * sc + w, 0, 0); t.fp8 = 1; t.dst = (bf16*)(F.ws + WS_WC + 64 * kb); return t; } s -= P0_S_CO;
    if (s < P0_S_AO) { const int sc = s >> 3, kb = s & 7; TItem t = titem_make(F.w_attn_out, AOW, D, (bf16*)(F.ws + WS_WA), kb * 64 + 8 * sc + w, 0, 0); t.fp8 = 1; t.dst = (bf16*)(F.ws + WS_WA + 64 * kb); return t; } s -= P0_S_AO;
    if (s < P0_S_WO) { const int sc = s >> 5, kb = s & 31; TItem t = titem_make(F.w_o, D, D, (bf16*)(F.ws + WS_WO), kb * 64 + 8 * sc + w, 0, 0); t.fp8 = 1; t.dst = (bf16*)(F.ws + WS_WO + 64 * kb); return t; } s -= P0_S_WO;
    const int e = s / P0_S_EX; int q = s % P0_S_EX;
    unsigned char* wgu = F.ws + WS_WGU + (size_t)e * 1024 * D; unsigned char* wd = F.ws + WS_WD + (size_t)e * D * DE;
    TItem t;
    if (q < 128) { const bool up = q >= 64; q &= 63; const int sc = q >> 5, kb = q & 31;
        const float* sp = up ? ((e < NE) ? F.w_exp_up + (size_t)e * D * DE : F.w_sh_up) : ((e < NE) ? F.w_exp_gate + (size_t)e * D * DE : F.w_sh_gate);
        t = titem_make(sp, D, DE, (bf16*)wgu, kb * 16 + 8 * sc + w, 1, up ? 4 : 0); t.dst = (bf16*)(wgu + 64 * kb); }
    else { q -= 128; const int sc = q >> 3, kb = q & 7;
        t = titem_make((e < NE) ? F.w_exp_down + (size_t)e * DE * D : F.w_sh_down, DE, D, (bf16*)wd, kb * 64 + 8 * sc + w, 0, 0); t.dst = (bf16*)(wd + 64 * kb); }
    t.fp8 = 1; return t;
}

constexpr int P0_S_MIX = P0_S_IN + P0_S_CO + P0_S_AO + P0_S_WO;
__device__ __forceinline__ void titem_load(const TItem& t, f32x4 (&v)[8], int lane) {
#pragma unroll
    for (int i = 0; i < 8; ++i) v[i] = __builtin_nontemporal_load((const f32x4*)(t.src + (size_t)(8 * i + (lane >> 3)) * t.N + 4 * (lane & 7)));
}
__device__ __forceinline__ void titem_flush(const f32x4 (&v)[8], LAS float* scr, int lane) {
#pragma unroll
    for (int i = 0; i < 8; ++i) { LAS float* p = scr + (8 * i + (lane >> 3)) * 33 + 4 * (lane & 7); p[0] = v[i].x; p[1] = v[i].y; p[2] = v[i].z; p[3] = v[i].w; }
    LDS_WAIT(); asm volatile("" ::: "memory");
}
__device__ __forceinline__ void titem_emit(const TItem& t, const LAS float* scr, int lane) {
    const int c = lane & 7;
#pragma unroll
    for (int j = 0; j < 4; ++j) { const int n = (lane >> 3) + 8 * j; const LAS float* s = scr + (8 * c) * 33 + n;
        const int dd = t.dd0 + n; const int drow = t.ilv ? (t.row_off + ((dd >> 2) << 3) + (dd & 3)) : (t.row_off + n);
        if (t.fp8) { const u32x2 o8 = {pk4_fp8(s[0 * 33] * W8_SCALE, s[1 * 33] * W8_SCALE, s[2 * 33] * W8_SCALE, s[3 * 33] * W8_SCALE), pk4_fp8(s[4 * 33] * W8_SCALE, s[5 * 33] * W8_SCALE, s[6 * 33] * W8_SCALE, s[7 * 33] * W8_SCALE)};
            __builtin_nontemporal_store(o8, (u32x2*)((unsigned char*)t.dst + (size_t)drow * t.K + 8 * c)); }
        else { u32x4 o; o.x = pk2(s[0 * 33], s[1 * 33]); o.y = pk2(s[2 * 33], s[3 * 33]); o.z = pk2(s[4 * 33], s[5 * 33]); o.w = pk2(s[6 * 33], s[7 * 33]);
            *(u32x4*)(t.dst + (size_t)drow * t.K + 8 * c) = o; } }
    LDS_WAIT(); asm volatile("" ::: "memory");
}
__device__ __forceinline__ void convert_steps(Frame& F, int s_lo, int s_hi, LAS float* scr) {
    const int lane = F.lane, w = F.wave;
    const int n = s_hi - s_lo; if (n <= 0) return;
    const int last = s_hi - 1;
    constexpr int NSL = 1;
    int idx[NSL]; TItem t[NSL]; f32x4 v[NSL][8];
#pragma unroll
    for (int q = 0; q < NSL; ++q) { idx[q] = (s_lo + q < last) ? s_lo + q : last; t[q] = titem_step(F, idx[q], w); titem_load(t[q], v[q], lane); }
    const int iters = (n + NSL - 1) / NSL;
    for (int p = 0; p < iters; ++p) {
#pragma unroll
        for (int q = 0; q < NSL; ++q) {
            titem_flush(v[q], scr, lane);
            const int nx = (idx[q] + NSL < last) ? idx[q] + NSL : last; const TItem tn = titem_step(F, nx, w);
            titem_load(tn, v[q], lane);
            titem_emit(t[q], scr, lane);
            t[q] = tn; idx[q] = nx;
        }
    }
}


struct XDec { const float* src; unsigned char* dst; int N, KBD, rowmul; };
__device__ __forceinline__ XDec xdec(const Frame& F, int s, int w) {
    const int e = s / P0_S_EX; int q = s % P0_S_EX; XDec d;
    if (q < 128) { const bool up = q >= 64; q &= 63; const int sc = q >> 5, kb = q & 31, n0 = 32 * (8 * sc + w), k0 = 64 * kb;
        const float* sp = up ? ((e < NE) ? F.w_exp_up + (size_t)e * D * DE : F.w_sh_up) : ((e < NE) ? F.w_exp_gate + (size_t)e * D * DE : F.w_sh_gate);
        d.src = sp + (size_t)k0 * DE + n0; d.dst = F.ws + WS_WGU + (size_t)e * 1024 * D + (size_t)((up ? 4 : 0) + 2 * n0) * D + k0; d.N = DE; d.KBD = D; d.rowmul = 8; }
    else { q -= 128; const int sc = q >> 3, kb = q & 7, n0 = 32 * (8 * sc + w), k0 = 64 * kb;
        d.src = ((e < NE) ? F.w_exp_down + (size_t)e * DE * D : F.w_sh_down) + (size_t)k0 * D + n0; d.dst = F.ws + WS_WD + (size_t)e * D * DE + (size_t)n0 * DE + k0; d.N = D; d.KBD = DE; d.rowmul = 4; }
    return d;
}
__device__ __forceinline__ void xload(const XDec& d, f32x4 (&v)[8], int lane) {
    const int q = lane >> 3, lane_off = ((q & 6) + 8 * (q & 1)) * d.N + 4 * (lane & 7);
#pragma unroll
    for (int i = 0; i < 8; ++i) v[i] = __builtin_nontemporal_load((const f32x4*)(d.src + (size_t)((16 * (i >> 1) + (i & 1)) * d.N) + lane_off));
}
__device__ __forceinline__ void xproc(const XDec& d, const f32x4 (&v)[8], LAS unsigned char* tile, int lane) {
    const int wlo = lane * 16;
#pragma unroll
    for (int i = 0; i < 8; ++i) *(LAS f32x4*)(tile + i * 1024 + (((i >> 1) & 1) ? (wlo ^ 64) : wlo)) = v[i];
    LDS_WAIT(); asm volatile("" ::: "memory");
    const int c = lane & 7, np = lane >> 3, rbase = (16 * (c >> 1) + (c & 1)) * 128 + ((np ^ (4 * ((c >> 1) & 1))) * 16);
    f32x4 r[8];
#pragma unroll
    for (int k = 0; k < 8; ++k) r[k] = *(const LAS f32x4*)(tile + rbase + ((k & 6) + 8 * (k & 1)) * 128);
    LDS_WAIT(); asm volatile("" ::: "memory");
    unsigned char* dp = d.dst + (size_t)(np * d.rowmul * d.KBD + 8 * c);
#pragma unroll
    for (int jj = 0; jj < 4; ++jj) {
        const u32x2 o8 = {pk4_fp8(r[0][jj] * W8_SCALE, r[1][jj] * W8_SCALE, r[2][jj] * W8_SCALE, r[3][jj] * W8_SCALE), pk4_fp8(r[4][jj] * W8_SCALE, r[5][jj] * W8_SCALE, r[6][jj] * W8_SCALE, r[7][jj] * W8_SCALE)};
        __builtin_nontemporal_store(o8, (u32x2*)(dp + (size_t)(jj * d.KBD))); }
}
__device__ __forceinline__ void convert_experts(Frame& F, int s_lo, int s_hi, LAS unsigned char* tile) {
    if (s_hi <= s_lo) return;
    const int lane = F.lane, w = __builtin_amdgcn_readfirstlane(F.wave), last = s_hi - 1;
    f32x4 va[8], vb[8];
    XDec d0 = xdec(F, s_lo, w); xload(d0, va, lane);
    for (int s = s_lo; s < s_hi; s += 2) {
        const XDec d1 = xdec(F, (s + 1 < last) ? s + 1 : last, w); xload(d1, vb, lane);
        xproc(d0, va, tile, lane);
        const XDec d2 = xdec(F, (s + 2 < last) ? s + 2 : last, w); xload(d2, va, lane);
        xproc(d1, vb, tile, lane);
        d0 = d2;
    }
}

__device__ __forceinline__ void p0_prologue(Frame& F) {
    const int gw = F.vcu * NWAVES + F.wave, NGW = F.G * NWAVES, lane = F.lane;
    {
        LAS float* red = (LAS float*)(F.lds);
        for (int cc = F.vcu; cc < 256; cc += F.G) {
            const int g = lane / 12, cs = lane % 12;
            f32x4 a0 = {0.f, 0.f, 0.f, 0.f}, a1 = {0.f, 0.f, 0.f, 0.f};
            if (g < 5) {
                const int rbase = 256 * F.wave;
                for (int ib = 0; ib < 4; ++ib) {
                    f32x4 w[13]; float s0[13], s1[13];
#pragma unroll
                    for (int u = 0; u < 13; ++u) { int rl = 5 * (13 * ib + u) + g; const bool ok = rl < 256; rl = ok ? rl : 255; const int r = rbase + rl;
                        w[u] = __builtin_nontemporal_load((const f32x4*)(F.w_ada + (size_t)r * (6 * D) + 48 * cc + 4 * cs)); const float c0 = F.c[r], c1 = F.c[D + r];
                        s0[u] = ok ? c0 * sigmoidf_(c0) : 0.f; s1[u] = ok ? c1 * sigmoidf_(c1) : 0.f; }
#pragma unroll
                    for (int u = 0; u < 13; ++u) { a0 += w[u] * s0[u]; a1 += w[u] * s1[u]; }
                }
            }
            LAS float* my = red + (F.wave * 64 + lane) * 8;
            my[0] = a0.x; my[1] = a0.y; my[2] = a0.z; my[3] = a0.w; my[4] = a1.x; my[5] = a1.y; my[6] = a1.z; my[7] = a1.w;
            __syncthreads();
            if (F.tid < 96) { const int b = F.tid / 48, col = F.tid % 48, cs2 = col >> 2, comp = col & 3; float s = 0.f;
                for (int w = 0; w < 8; ++w) for (int gg = 0; gg < 5; ++gg) s += red[(w * 64 + gg * 12 + cs2) * 8 + b * 4 + comp];
                ((float*)(F.ws + WS_MOD))[b * 6 * D + 48 * cc + col] = s + F.b_ada[48 * cc + col]; }
            __syncthreads();
        }
    }
    {
        f32x2* tab = (f32x2*)(F.ws + WS_ROPE);
        for (int idx = (F.vcu * NTHREADS + F.tid); idx < NT * 64; idx += F.G * NTHREADS) { const int tok = idx >> 6, i = idx & 63;
            const float inv = exp2f(-(float)i * (13.287712379549449f / 64.0f));
            const double rev = (double)F.positions[tok] * (double)inv * 0.15915494309189535; const float fr = (float)(rev - floor(rev));
            tab[idx] = (f32x2){__builtin_amdgcn_cosf(fr), __builtin_amdgcn_sinf(fr)}; }
    }
    {
        bf16* wrh = (bf16*)(F.ws + WS_WRH); bf16* wrl = (bf16*)(F.ws + WS_WRL);
        for (int idx = F.vcu * NTHREADS + F.tid; idx < NE * (D / 8); idx += F.G * NTHREADS) { const int e = idx / (D / 8), kc = idx % (D / 8);
            unsigned hw[4], lw[4];
#pragma unroll
            for (int i = 0; i < 4; ++i) { const float a = F.w_router[(size_t)(8 * kc + 2 * i) * NE + e], b = F.w_router[(size_t)(8 * kc + 2 * i + 1) * NE + e];
                const unsigned ha = f2bf(a), hb = f2bf(b); hw[i] = ha | (hb << 16); lw[i] = pk2(a - __builtin_bit_cast(float, ha << 16), b - __builtin_bit_cast(float, hb << 16)); }
            const size_t fo = ((size_t)((e >> 4) * 64 + (kc >> 2)) * 64 + (e & 15) + 16 * (kc & 3)) * 8;
            *(u32x4*)(wrh + fo) = (u32x4){hw[0], hw[1], hw[2], hw[3]}; *(u32x4*)(wrl + fo) = (u32x4){lw[0], lw[1], lw[2], lw[3]}; }
    }
    convert_steps(F, (int)(((long)F.vcu * P0_S_MIX) / F.G), (int)(((long)(F.vcu + 1) * P0_S_MIX) / F.G), (LAS float*)(F.lds + 16384 + F.wave * 16384));
}

__device__ __forceinline__ void p1_hnorm(Frame& F) {
    const int gw = F.vcu * NWAVES + F.wave, NGW = F.G * NWAVES;
    const float* mod = (const float*)(F.ws + WS_MOD); unsigned char* H = F.ws + WS_H;
    for (int t0 = gw; t0 < NT; t0 += 2 * NGW) {
        f32x4 v[2][8]; int tt[2];
#pragma unroll
        for (int k = 0; k < 2; ++k) { tt[k] = (t0 + k * NGW < NT) ? t0 + k * NGW : t0; const f32x4* xr = (const f32x4*)(F.x + (size_t)tt[k] * D) + F.lane;
#pragma unroll
            for (int j = 0; j < 8; ++j) v[k][j] = __builtin_nontemporal_load(xr + 64 * j); }
#pragma unroll
        for (int k = 0; k < 2; ++k) { const int t = tt[k], b = t / SEQ; float ss = 0.f;
#pragma unroll
            for (int j = 0; j < 8; ++j) ss += (v[k][j].x * v[k][j].x + v[k][j].y * v[k][j].y) + (v[k][j].z * v[k][j].z + v[k][j].w * v[k][j].w);
            const float rstd = rsqrtf(wave_sum(ss) * (1.f / D) + EPS);
            unsigned* o = (unsigned*)(H + (size_t)t * D) + F.lane;
            if (k == 0 || t0 + NGW < NT) {
#pragma unroll
                for (int j = 0; j < 8; ++j) { const int col = 4 * F.lane + 256 * j;
                    const f32x4 g = *(const f32x4*)(F.norm_mix_g + col), sh = *(const f32x4*)(mod + b * 6 * D + col), sc = *(const f32x4*)(mod + b * 6 * D + D + col);
                    const f32x4 y = v[k][j] * rstd * g * (sc + 1.0f) + sh;
                    o[64 * j] = pk4_fp8(y.x, y.y, y.z, y.w); } }
        }
    }
}

struct Unit { int pm, pn, e, srow0, nvalid, ord; };

struct SchedPlain {
    const bf16* A; const bf16* Bt; int K, KB; int nM, nN, nwg, G, c; int gs = 8;
    __device__ __forceinline__ void init(const bf16* A_, const bf16* Bt_, int M, int N, int K_, int G_, int c_) { A = A_; Bt = Bt_; K = K_; KB = 2 * K_; nM = M / 256; nN = N / 256; nwg = nM * nN; G = G_; c = c_; }
    __device__ __forceinline__ bool next(int i, Unit& u) const {
        const long L = (long)i * G + c; if (L >= nwg) return false;
        int wgid = (int)L; { const int q = nwg / 8, r = nwg % 8, xcd = wgid % 8, off = wgid / 8; wgid = (xcd < r ? xcd * (q + 1) : r * (q + 1) + (xcd - r) * q) + off; }
        const int nig = gs * nN, gid = wgid / nig, fm = gid * gs, gsz = (nM - fm) < gs ? (nM - fm) : gs;
        u.pm = fm + ((wgid % nig) % gsz); u.pn = (wgid % nig) / gsz; u.e = 0; u.srow0 = 256 * u.pm; u.nvalid = 256; u.ord = i; return true;
    }
    __device__ __forceinline__ const char* a_base(const Unit& u) const { return (const char*)(A + (size_t)(256 * u.pm) * K); }
    __device__ __forceinline__ const char* b_base(const Unit& u) const { return (const char*)(Bt + (size_t)(256 * u.pn) * K); }
    __device__ __forceinline__ void a_offs(const Unit&, const int (&R)[2], const int (&C)[2], unsigned (&v)[2][2]) const {
#pragma unroll
        for (int h = 0; h < 2; ++h)
#pragma unroll
            for (int i = 0; i < 2; ++i) v[h][i] = (unsigned)((R[i] + 128 * h) * K + C[i]) * 2u; }
};
struct SchedMoE {
    const unsigned char* A; const unsigned char* Bt; const int* list; int KB, NTN, G, c, nwg; size_t bstride; bool gather;
    const LAS int* ll;
    const LAS int* tp; const LAS int* cnt; const LAS int* off;
    __device__ __forceinline__ bool next(int i, Unit& u) const {
        const long L = (long)i * G + c; if (L >= nwg) return false;
        int wgid = (int)L; { const int q = nwg / 8, r = nwg % 8, xcd = wgid % 8, o2 = wgid / 8; wgid = (xcd < r ? xcd * (q + 1) : r * (q + 1) + (xcd - r) * q) + o2; }
        const int tile = wgid / NTN; u.pn = wgid % NTN;
        int e = 0;
#pragma unroll
        for (int st = 64; st >= 1; st >>= 1) { const int c2 = e + st; if (c2 <= NE && tp[c2] <= tile) e = c2; }
        u.e = e; u.pm = tile - tp[e]; u.srow0 = off[e] + 256 * u.pm; const int rem = cnt[e] - 256 * u.pm; u.nvalid = rem < 256 ? rem : 256; u.ord = i; return true;
    }
    __device__ __forceinline__ const char* a_base(const Unit& u) const { return gather ? (const char*)A : (const char*)(A + (size_t)u.srow0 * KB); }
    __device__ __forceinline__ const char* b_base(const Unit& u) const { return (const char*)(Bt + (size_t)u.e * bstride + (size_t)(256 * u.pn) * KB); }
    __device__ __forceinline__ void a_offs(const Unit& u, const int (&R)[2], const int (&C)[2], unsigned (&v)[2][2]) const {
#pragma unroll
        for (int h = 0; h < 2; ++h)
#pragma unroll
            for (int i = 0; i < 2; ++i) { const int rl = R[i] + 128 * h; int row = rl;
                if (gather) row = ll[u.ord * 256 + rl];
                v[h][i] = (unsigned)(row * KB + C[i] * 2); } }
};

constexpr int HTB = 128 * 64 * 2;
__device__ __forceinline__ int lds_byte(int r, int c) { const int st = (r >> 4) * 2 + (c >> 5), rr = r & 15, cc = c & 31, ob = rr * 64 + cc * 2; return st * 1024 + (ob ^ (((ob >> 9) & 1) << 5)); }
__device__ __forceinline__ void stage_rc(int b, int& R, int& C) { const int st = b / 1024, sb = b % 1024, swz = sb ^ (((sb >> 9) & 1) << 5); R = (st >> 1) * 16 + swz / 64; C = (st & 1) * 32 + (swz % 64) / 2; }

template <class Epi, class Sched, bool ALIGN_EPI, bool FP8>
__device__ __forceinline__ void gemm_phase(LAS unsigned char* lds, const Sched& S, const Epi& E) {
    const int tid = threadIdx.x, wid = __builtin_amdgcn_readfirstlane(tid >> 6), lane = tid & 63, wr = wid >> 2, wc = wid & 3, fr = lane & 15, fq = lane >> 4;
    const int K = S.KB / 2, nt = S.KB / 128;
    int Rr[2], Cc[2]; unsigned voffB[2];
#pragma unroll
    for (int i = 0; i < 2; ++i) { stage_rc(tid * 16 + i * 8192, Rr[i], Cc[i]); int Rb = Epi::PERM ? ((Rr[i] & ~31) + perm32(Rr[i] & 31)) : Rr[i];
        if constexpr (Epi::WIDE) Rb = (Rr[i] >> 5) * 64 + 16 * ((Rr[i] & 15) >> 2) + 4 * ((Rr[i] >> 4) & 1) + (Rr[i] & 3);
        voffB[i] = (unsigned)(Rb * K + Cc[i]) * 2u; }
    const size_t kstep = (size_t)(64 * 2);
    const size_t hstep = (size_t)(Epi::WIDE ? 8 : 128) * K * 2;
    const unsigned ldsw = (unsigned)wid * 1024u;
    const int aoff = lds_byte(wr * 64 + fr, fq * 8), boff = lds_byte(wc * 32 + fr, fq * 8);
#define PG8_SA(b, h) (((b) * 2 + (h)) * HTB)
#define PG8_SB(b, h) ((4 + (b) * 2 + (h)) * HTB)
#define PG8_STAGE(bufoff, gbase, voff) do { _Pragma("unroll") for (int _i = 0; _i < 2; ++_i) \
        __builtin_amdgcn_global_load_lds((const unsigned*)((const char*)(gbase) + (voff)[_i]), (LAS unsigned*)(lds + (bufoff) + ldsw + _i * 8192), 16, 0, 0); } while (0)
#define PG8_LD8(p) __builtin_shufflevector(*(const LAS u32x4*)(p), *(const LAS u32x4*)((p) + 1024), 0, 1, 2, 3, 4, 5, 6, 7)
#define PG8_LDA(dst, b, h) do { if constexpr (FP8) { _Pragma("unroll") for (int m = 0; m < 4; ++m) dst##8[m] = PG8_LD8(lds + PG8_SA(b, h) + aoff + m * 2048); } \
        else { _Pragma("unroll") for (int m = 0; m < 4; ++m) _Pragma("unroll") for (int k = 0; k < 2; ++k) dst[m][k] = *(const LAS bf16x8*)(lds + PG8_SA(b, h) + aoff + m * 2048 + k * 1024); } } while (0)
#define PG8_LDB(dst, b, h) do { if constexpr (FP8) { _Pragma("unroll") for (int n = 0; n < 2; ++n) dst##8[n] = PG8_LD8(lds + PG8_SB(b, h) + boff + n * 2048); } \
        else { _Pragma("unroll") for (int n = 0; n < 2; ++n) _Pragma("unroll") for (int k = 0; k < 2; ++k) dst[n][k] = *(const LAS bf16x8*)(lds + PG8_SB(b, h) + boff + n * 2048 + k * 1024); } } while (0)
#define PG8_MMA(ai, bj, At, Bt) do { __builtin_amdgcn_s_setprio(1); _Pragma("unroll") for (int m = 0; m < 4; ++m) _Pragma("unroll") for (int n = 0; n < 2; ++n) { \
        if constexpr (FP8) asm volatile("v_mfma_scale_f32_16x16x128_f8f6f4 %0, %1, %2, %0, %3, %4 op_sel_hi:[0,0,0]" : "+v"(acc[ai][bj][m][n]) : "v"(Bt##8[n]), "v"(At##8[m]), "v"(sclW), "v"(sclO)); \
        else { _Pragma("unroll") for (int k = 0; k < 2; ++k) acc[ai][bj][m][n] = __builtin_amdgcn_mfma_f32_16x16x32_bf16(Bt[n][k], At[m][k], acc[ai][bj][m][n], 0, 0, 0); } } \
        __builtin_amdgcn_s_setprio(0); } while (0)
#define PG8_WAIT_V(n) asm volatile("s_waitcnt vmcnt(" #n ")" ::: "memory")
#define PG8_WAIT_L(n) asm volatile("s_waitcnt lgkmcnt(" #n ")" ::: "memory")
#define PG8_BAR __builtin_amdgcn_s_barrier()
#define PG8_SCHED __builtin_amdgcn_sched_barrier(0)
    Unit cur, nxt; int ui = 0;
    if (!S.next(0, cur)) return;
    f32x4 acc[2][2][4][2];
#pragma unroll
    for (int a = 0; a < 2; ++a)
#pragma unroll
        for (int b = 0; b < 2; ++b)
#pragma unroll
            for (int m = 0; m < 4; ++m)
#pragma unroll
                for (int n = 0; n < 2; ++n) acc[a][b][m][n] = (f32x4){0.f, 0.f, 0.f, 0.f};
    bf16x8 At[4][2], B0[2][2], B1[2][2];
    typedef unsigned u32x8 __attribute__((ext_vector_type(8)));
    u32x8 At8[4], B08[2], B18[2];
    int sclW = SCALE_W8, sclO = SCALE_ONE; asm volatile("" : "+v"(sclW), "+v"(sclO));
    unsigned vAc[2][2], vAn[2][2];
    S.a_offs(cur, Rr, Cc, vAc);
    const char* cA = S.a_base(cur); const char* cB = S.b_base(cur);
    PG8_STAGE(PG8_SB(0, 0), cB, voffB); PG8_STAGE(PG8_SB(0, 1), cB + hstep, voffB); PG8_STAGE(PG8_SA(0, 0), cA, vAc[0]); PG8_STAGE(PG8_SA(0, 1), cA, vAc[1]);
    if (wr == 1) PG8_BAR;
    PG8_WAIT_V(2); PG8_BAR;
    PG8_STAGE(PG8_SB(1, 0), cB + kstep, voffB); PG8_STAGE(PG8_SA(1, 0), cA + kstep, vAc[0]); PG8_STAGE(PG8_SB(1, 1), cB + hstep + kstep, voffB);
    PG8_WAIT_V(6); PG8_BAR;
    for (;;) {
        const bool has_next = S.next(ui + 1, nxt);
        const char* nA = has_next ? S.a_base(nxt) : cA; const char* nB = has_next ? S.b_base(nxt) : cB;
        if (has_next) S.a_offs(nxt, Rr, Cc, vAn);
        else {
#pragma unroll
            for (int h = 0; h < 2; ++h)
#pragma unroll
                for (int i = 0; i < 2; ++i) vAn[h][i] = vAc[h][i]; }
        for (int t = 0; t < nt; t += 2) {
            const bool last = (t == nt - 2);
            const char* a1 = cA + (size_t)(t + 1) * kstep;
            const char* a2 = last ? nA : cA + (size_t)(t + 2) * kstep; const char* b2 = last ? nB : cB + (size_t)(t + 2) * kstep;
            const char* a3 = a2 + kstep; const char* b3 = b2 + kstep;
            PG8_LDB(B0, 0, 0); PG8_LDB(B1, 0, 1); PG8_SCHED; PG8_LDA(At, 0, 0); PG8_STAGE(PG8_SA(1, 1), a1, vAc[1]);
            PG8_WAIT_V(8); PG8_WAIT_L(0); PG8_BAR; PG8_MMA(0, 0, At, B0); PG8_MMA(0, 1, At, B1); PG8_BAR; PG8_SCHED;
            if (last) {
#pragma unroll
                for (int h = 0; h < 2; ++h)
#pragma unroll
                    for (int i = 0; i < 2; ++i) { asm volatile("" : "+v"(vAn[h][i])); vAc[h][i] = vAn[h][i]; } }
            PG8_LDA(At, 0, 1); PG8_STAGE(PG8_SB(0, 0), b2, voffB); PG8_STAGE(PG8_SB(0, 1), b2 + hstep, voffB); PG8_STAGE(PG8_SA(0, 0), a2, vAc[0]);
            PG8_WAIT_V(8); PG8_WAIT_L(0); PG8_BAR; if (cur.nvalid > 128) { PG8_MMA(1, 0, At, B0); PG8_MMA(1, 1, At, B1); } PG8_BAR; PG8_SCHED;
            PG8_LDB(B0, 1, 0); PG8_LDB(B1, 1, 1); PG8_SCHED; PG8_LDA(At, 1, 0); PG8_STAGE(PG8_SA(0, 1), a2, vAc[1]);
            PG8_WAIT_V(8); PG8_WAIT_L(0); PG8_BAR; PG8_MMA(0, 0, At, B0); PG8_MMA(0, 1, At, B1); PG8_BAR; PG8_SCHED;
            PG8_LDA(At, 1, 1); PG8_STAGE(PG8_SB(1, 0), b3, voffB); PG8_STAGE(PG8_SB(1, 1), b3 + hstep, voffB); PG8_STAGE(PG8_SA(1, 0), a3, vAc[0]);
            PG8_WAIT_V(8); PG8_WAIT_L(0); PG8_BAR; if (cur.nvalid > 128) { PG8_MMA(1, 0, At, B0); PG8_MMA(1, 1, At, B1); } PG8_BAR; PG8_SCHED;
        }
        if constexpr (ALIGN_EPI) { if (wr == 0) PG8_BAR; }
        if constexpr (FP8) asm volatile("s_nop 15\n\ts_nop 15" ::: "memory");
        E(acc, cur, wr, wc, fr, fq);
        if (!has_next) break;
#pragma unroll
        for (int a = 0; a < 2; ++a)
#pragma unroll
            for (int b = 0; b < 2; ++b)
#pragma unroll
                for (int m = 0; m < 4; ++m)
#pragma unroll
                    for (int n = 0; n < 2; ++n) acc[a][b][m][n] = (f32x4){0.f, 0.f, 0.f, 0.f};
        cur = nxt; cA = nA; cB = nB; ++ui;
        if constexpr (ALIGN_EPI) { if (wr == 1) PG8_BAR; }
    }
    PG8_WAIT_V(0);
    if constexpr (!ALIGN_EPI) { if (wr == 0) PG8_BAR; }
    PG8_BAR;
#undef PG8_SA
#undef PG8_SB
#undef PG8_STAGE
#undef PG8_LDA
#undef PG8_LDB
#undef PG8_MMA
#undef PG8_WAIT_V
#undef PG8_WAIT_L
#undef PG8_BAR
#undef PG8_SCHED
}

__device__ __forceinline__ u32x4 pack8(const f32x4 a, const f32x4 b) { return (u32x4){pk2(a.x, a.y), pk2(a.z, a.w), pk2(b.x, b.y), pk2(b.z, b.w)}; }
struct EpiProj {
    static constexpr bool PERM = true, WIDE = false;
    bf16* P; const f32x2* rope;
    __device__ __forceinline__ void operator()(const f32x4 (&acc)[2][2][4][2], const Unit& u, int wr, int wc, int fr, int fq) const {
        const int row0 = u.pm * 256 + wr * 64 + fr, col0 = u.pn * 256 + wc * 32 + 8 * fq;
        const bool isq = (u.pn >= COL_Q / 256 && u.pn < COL_K / 256), isk = (u.pn >= COL_K / 256 && u.pn < COL_VA / 256);
        const float qs = isq ? 0.08838834764831845f : 1.0f;
#pragma unroll
        for (int ai = 0; ai < 2; ++ai)
#pragma unroll
            for (int m = 0; m < 4; ++m) { const int row = row0 + ai * 128 + m * 16; bf16* rowp = P + (size_t)row * INC + col0;
                f32x4 cs0 = {1.f, 0.f, 1.f, 0.f}, cs1 = {1.f, 0.f, 1.f, 0.f};
                if (isq || isk) { const f32x4* rp = (const f32x4*)(rope + (size_t)row * 64 + 16 * wc + 4 * fq); cs0 = rp[0]; cs1 = rp[1]; }
#pragma unroll
                for (int bj = 0; bj < 2; ++bj) { f32x4 t1 = acc[ai][bj][m][0], t2 = acc[ai][bj][m][1];
                    if (isq || isk) { const f32x4 co = {cs0.x, cs0.z, cs1.x, cs1.z}, si = {cs0.y, cs0.w, cs1.y, cs1.w};
                        const f32x4 o1 = (t1 * co - t2 * si) * qs, o2 = (t2 * co + t1 * si) * qs; t1 = o1; t2 = o2; }
                    *(u32x4*)(rowp + bj * 128) = pack8(t1, t2); } }
    }
};
template <bool ADD> struct EpiGate {
    static constexpr bool PERM = true, WIDE = false;
    const bf16* P; int gcol; const bf16* prev; bf16* O;
    __device__ __forceinline__ void operator()(const f32x4 (&acc)[2][2][4][2], const Unit& u, int wr, int wc, int fr, int fq) const {
        const int row0 = u.pm * 256 + wr * 64 + fr, col0 = u.pn * 256 + wc * 32 + 8 * fq;
#pragma unroll
        for (int ai = 0; ai < 2; ++ai)
#pragma unroll
            for (int m = 0; m < 4; ++m) { const int row = row0 + ai * 128 + m * 16;
#pragma unroll
                for (int bj = 0; bj < 2; ++bj) { const int col = col0 + bj * 128;
                    const u32x4 gv = *(const u32x4*)(P + (size_t)row * INC + gcol + col);
                    f32x4 g0 = {bflo(gv.x), bfhi(gv.x), bflo(gv.y), bfhi(gv.y)}, g1 = {bflo(gv.z), bfhi(gv.z), bflo(gv.w), bfhi(gv.w)};
#pragma unroll
                    for (int j = 0; j < 4; ++j) { g0[j] = sigmoidf_(g0[j]); g1[j] = sigmoidf_(g1[j]); }
                    f32x4 o0 = g0 * acc[ai][bj][m][0], o1 = g1 * acc[ai][bj][m][1];
                    if (ADD) { const u32x4 pv = *(const u32x4*)(prev + (size_t)row * D + col);
                        o0 += (f32x4){bflo(pv.x), bfhi(pv.x), bflo(pv.y), bfhi(pv.y)}; o1 += (f32x4){bflo(pv.z), bfhi(pv.z), bflo(pv.w), bfhi(pv.w)}; }
                    if constexpr (ADD) *(u32x2*)((unsigned char*)O + (size_t)row * D + col) = (u32x2){pk4_fp8(o0.x, o0.y, o0.z, o0.w), pk4_fp8(o1.x, o1.y, o1.z, o1.w)};
                    else *(u32x4*)(O + (size_t)row * D + col) = pack8(o0, o1); } }
    }
};
struct EpiX1 {
    static constexpr bool PERM = false, WIDE = false;
    const float* x; const float* gate; float* O;
    __device__ __forceinline__ void operator()(const f32x4 (&acc)[2][2][4][2], const Unit& u, int wr, int wc, int fr, int fq) const {
        const int row0 = u.pm * 256 + wr * 64 + fr, col0 = u.pn * 256 + wc * 32 + 4 * fq; const int b = (u.pm * 256) / SEQ;
        f32x4 gv[2][2];
#pragma unroll
        for (int bj = 0; bj < 2; ++bj)
#pragma unroll
            for (int n = 0; n < 2; ++n) gv[bj][n] = *(const f32x4*)(gate + b * 6 * D + col0 + bj * 128 + n * 16);
#pragma unroll
        for (int ai = 0; ai < 2; ++ai)
#pragma unroll
            for (int m = 0; m < 4; ++m) { const size_t off = (size_t)(row0 + ai * 128 + m * 16) * D + col0;
#pragma unroll
                for (int bj = 0; bj < 2; ++bj)
#pragma unroll
                    for (int n = 0; n < 2; ++n) { const f32x4 xv = *(const f32x4*)(x + off + bj * 128 + n * 16);
                        *(f32x4*)(O + off + bj * 128 + n * 16) = xv + gv[bj][n] * acc[ai][bj][m][n]; } }
    }
};
struct EpiGU {
    static constexpr bool PERM = true, WIDE = true;
    bf16* Hs;
    __device__ __forceinline__ void operator()(const f32x4 (&acc)[2][2][4][2], const Unit& u, int wr, int wc, int fr, int fq) const {
        const int j0 = u.pn * 128 + wc * 32 + 8 * fq;
#pragma unroll
        for (int ai = 0; ai < 2; ++ai)
#pragma unroll
            for (int m = 0; m < 4; ++m) { const int rl = ai * 128 + wr * 64 + m * 16 + fr;
                if (rl < u.nvalid) { unsigned w[2];
#pragma unroll
                    for (int bj = 0; bj < 2; ++bj) { const f32x4 g = acc[ai][bj][m][0], up = acc[ai][bj][m][1]; f32x4 h;
#pragma unroll
                        for (int j = 0; j < 4; ++j) h[j] = g[j] * sigmoidf_(g[j]) * up[j];
                        w[bj] = pk4_fp8(h.x, h.y, h.z, h.w); }
                    *(u32x2*)((unsigned char*)Hs + (size_t)(u.srow0 + rl) * DE + j0) = (u32x2){w[0], w[1]}; } }
    }
};
struct EpiDown {
    static constexpr bool PERM = true, WIDE = true;
    bf16* Y;
    __device__ __forceinline__ void operator()(const f32x4 (&acc)[2][2][4][2], const Unit& u, int wr, int wc, int fr, int fq) const {
        const int col0 = u.pn * 256 + wc * 64 + 16 * fq;
#pragma unroll
        for (int ai = 0; ai < 2; ++ai)
#pragma unroll
            for (int m = 0; m < 4; ++m) { const int rl = ai * 128 + wr * 64 + m * 16 + fr;
                if (rl < u.nvalid) { const f32x4 a0 = acc[ai][0][m][0], b0 = acc[ai][0][m][1], a1 = acc[ai][1][m][0], b1 = acc[ai][1][m][1];
                    *(u32x4*)((unsigned char*)Y + (size_t)(u.srow0 + rl) * D + col0) =
                        (u32x4){pk4_fp8(a0.x, a0.y, a0.z, a0.w), pk4_fp8(b0.x, b0.y, b0.z, b0.w), pk4_fp8(a1.x, a1.y, a1.z, a1.w), pk4_fp8(b1.x, b1.y, b1.z, b1.w)}; } }
    }
};

constexpr size_t WS_OG = 740 * MiB;
constexpr size_t WS_LSE = 764 * MiB;
struct AttnUnit { int tok0, i0, r, head; };
__device__ __forceinline__ AttnUnit attn_unit(int unit) {
    const int b = unit / 384, rem = unit % 384, g = rem >> 7, rem2 = rem & 127, hd = rem2 >> 5, q32 = rem2 & 31;
    const int nbg = 32 >> (2 * g), rho = q32 / nbg, blk = q32 % nbg;
    AttnUnit u; u.r = 1 << (2 * g); u.head = 4 * g + hd; u.tok0 = b * SEQ + rho; u.i0 = blk * 128; return u;
}
__device__ __forceinline__ void attn_issue_k(const bf16* P, LAS unsigned char* Kt, const AttnUnit& u, int w, int lane) {
#pragma unroll
    for (int i = 0; i < 8; ++i) { const int st = w + 8 * i, kb = st >> 2, ks = st & 3, sb = lane * 16, swz = sb ^ (((sb >> 9) & 1) << 5), row = swz >> 6, cch = (swz & 63) >> 1;
        int ksub = u.i0 + 16 * kb + row - 128; ksub = ksub < 0 ? 0 : ksub;
        const bf16* gp = P + (size_t)(u.tok0 + ksub * u.r) * INC + COL_K + u.head * HD + 32 * ks + cch;
        __builtin_amdgcn_global_load_lds((const unsigned*)gp, (LAS unsigned*)(Kt + w * 1024 + i * 8192), 16, 0, 0); }
}
__device__ __forceinline__ void attn_load_qv(const bf16* P, const AttnUnit& u, int w, int lane, bf16x8 (&Qf)[4], u32x4 (&va)[4], u32x4 (&vb)[4]) {
    const int fr = lane & 15, fq = lane >> 4;
    const int qtok = u.tok0 + (u.i0 + 16 * w + fr) * u.r;
#pragma unroll
    for (int ks = 0; ks < 4; ++ks) Qf[ks] = *(const bf16x8*)(P + (size_t)qtok * INC + COL_Q + u.head * HD + 32 * ks + 8 * fq);
    const int pair = lane & 15, key = 32 * w + 2 * pair;
    int ks0 = u.i0 + key - 128, ks1 = ks0 + 1; ks0 = ks0 < 0 ? 0 : ks0; ks1 = ks1 < 0 ? 0 : ks1;
    const bf16* v0p = P + (size_t)(u.tok0 + ks0 * u.r) * INC + COL_VA + u.head * HD; const bf16* v1p = P + (size_t)(u.tok0 + ks1 * u.r) * INC + COL_VA + u.head * HD;
#pragma unroll
    for (int it = 0; it < 4; ++it) { const int c = (lane >> 4) + 4 * it; va[it] = *(const u32x4*)(v0p + 8 * c); vb[it] = *(const u32x4*)(v1p + 8 * c); }
}
__device__ __forceinline__ void attn_write_v(LAS unsigned char* Vt, int w, int lane, const u32x4 (&va)[4], const u32x4 (&vb)[4]) {
    const int pair = lane & 15; const int slot = 8 * ((pair & 7) >> 1) + 4 * (pair >> 3) + 2 * (pair & 1); const bool odd = (lane >> 4) & 1;
#pragma unroll
    for (int it = 0; it < 4; ++it) { const int c = (lane >> 4) + 4 * it;
        const unsigned a4[4] = {va[it].x, va[it].y, va[it].z, va[it].w}, b4[4] = {vb[it].x, vb[it].y, vb[it].z, vb[it].w};
#pragma unroll
        for (int j = 0; j < 8; ++j) {
            const unsigned aw = a4[j >> 1], bw = b4[j >> 1];
            const unsigned e_lo = (aw & 0xffffu) | (bw << 16), e_hi = (aw >> 16) | (bw & 0xffff0000u);
            const unsigned ej = (j & 1) ? e_hi : e_lo, ejx = (j & 1) ? e_lo : e_hi;
            const unsigned word = odd ? ejx : ej; const int d = 8 * c + (odd ? (j ^ 1) : j);
            const int o2 = (d & 15) * 64 + slot * 2, addr = ((d >> 4) * 8 + w) * 1024 + (o2 ^ (((o2 >> 9) & 1) << 5));
            *(LAS unsigned*)(Vt + addr) = word; } }
}
__device__ __forceinline__ void p3_attn(Frame& F) {
    const bf16* P = (const bf16*)(F.ws + WS_PROJ); bf16* OG = (bf16*)(F.ws + WS_OG); float* LSE = (float*)(F.ws + WS_LSE);
    LAS unsigned char* Kt = F.lds; LAS unsigned char* Vt = F.lds + 65536;
    const int lane = F.lane, w = F.wave, fr = lane & 15, fq = lane >> 4;
    const int ob = fr * 64 + fq * 16, foff = ob ^ (((ob >> 9) & 1) << 5);
    int unit = F.vcu; if (unit >= 768) return;
    AttnUnit cu = attn_unit(unit);
    bf16x8 Qf[4], Qn[4]; u32x4 va[4], vb[4];
    attn_issue_k(P, Kt, cu, w, lane);
    attn_load_qv(P, cu, w, lane, Qf, va, vb);
    attn_write_v(Vt, w, lane, va, vb);
    for (;;) {
        const int nunit = unit + F.G; const bool more = nunit < 768; const AttnUnit nu = attn_unit(more ? nunit : unit);
        asm volatile("s_waitcnt vmcnt(0) lgkmcnt(0)" ::: "memory"); __syncthreads();
        attn_load_qv(P, nu, w, lane, Qn, va, vb);
        const int p0 = w >> 1;
        f32x4 sacc[10];
#pragma unroll
        for (int ff = 0; ff < 10; ++ff) { sacc[ff] = (f32x4){0.f, 0.f, 0.f, 0.f};
#pragma unroll
            for (int ks = 0; ks < 4; ++ks) { const bf16x8 Kf = *(const LAS bf16x8*)(Kt + ((2 * p0 + ff) * 4 + ks) * 1024 + foff);
                sacc[ff] = __builtin_amdgcn_mfma_f32_16x16x32_bf16(Kf, Qf[ks], sacc[ff], 0, 0, 0); } }
        asm volatile("s_waitcnt lgkmcnt(0)" ::: "memory"); __syncthreads();
        if (more) attn_issue_k(P, Kt, nu, w, lane);
        const int qi = 16 * w + fr; float mx = -1e30f;
#pragma unroll
        for (int ff = 0; ff < 10; ++ff)
#pragma unroll
            for (int rr = 0; rr < 4; ++rr) { const int kj = 16 * (2 * p0 + ff) + 4 * fq + rr; const bool valid = (kj >= qi) && (kj <= qi + 128) && (cu.i0 + kj >= 128);
                sacc[ff][rr] = valid ? sacc[ff][rr] : -1e30f; mx = fmaxf(mx, sacc[ff][rr]); }
        mx = fmaxf(mx, __shfl_xor(mx, 16)); mx = fmaxf(mx, __shfl_xor(mx, 32));
        float sm = 0.f;
#pragma unroll
        for (int ff = 0; ff < 10; ++ff)
#pragma unroll
            for (int rr = 0; rr < 4; ++rr) { const float pv = (sacc[ff][rr] > -1e29f) ? __expf(sacc[ff][rr] - mx) : 0.f; sacc[ff][rr] = pv; sm += pv; }
        sm += __shfl_xor(sm, 16); sm += __shfl_xor(sm, 32);
        f32x4 oacc[8];
#pragma unroll
        for (int db = 0; db < 8; ++db) oacc[db] = (f32x4){0.f, 0.f, 0.f, 0.f};
#pragma unroll
        for (int pp = 0; pp < 5; ++pp) { const u32x4 pw = pack8(sacc[2 * pp], sacc[2 * pp + 1]); const bf16x8 Pb = __builtin_bit_cast(bf16x8, pw);
#pragma unroll
            for (int db = 0; db < 8; ++db) { const bf16x8 Vf = *(const LAS bf16x8*)(Vt + (db * 8 + p0 + pp) * 1024 + foff);
                oacc[db] = __builtin_amdgcn_mfma_f32_16x16x32_bf16(Vf, Pb, oacc[db], 0, 0, 0); } }
        const float inv = 1.0f / sm;
        const int qtok = cu.tok0 + (cu.i0 + 16 * w + fr) * cu.r;
        bf16* orow = OG + (size_t)qtok * ATTW + cu.head * HD + 4 * fq;
#pragma unroll
        for (int db = 0; db < 8; ++db) { const f32x4 o = oacc[db] * inv; *(u32x2*)(orow + 16 * db) = (u32x2){pk2(o.x, o.y), pk2(o.z, o.w)}; }
        if (fq == 0) LSE[(size_t)qtok * 12 + cu.head] = mx + __logf(sm);
        if (!more) break;
        asm volatile("s_waitcnt lgkmcnt(0)" ::: "memory"); __syncthreads();
        attn_write_v(Vt, w, lane, va, vb);
#pragma unroll
        for (int ks = 0; ks < 4; ++ks) Qf[ks] = Qn[ks];
        cu = nu; unit = nunit;
    }
    __syncthreads();
}
__device__ __forceinline__ void p4_combine(Frame& F) {
    const bf16* OG = (const bf16*)(F.ws + WS_OG); const float* LSE = (const float*)(F.ws + WS_LSE); bf16* AO = (bf16*)(F.ws + WS_AO);
    for (int idx = F.vcu * NTHREADS + F.tid; idx < NT * 64; idx += F.G * NTHREADS) { const int t = idx >> 6, j = (idx >> 4) & 3, c8 = (idx & 15) * 8;
        const float l0 = LSE[t * 12 + j], l1 = LSE[t * 12 + 4 + j], l2 = LSE[t * 12 + 8 + j]; const float M = fmaxf(l0, fmaxf(l1, l2));
        float e[3] = {__expf(l0 - M), __expf(l1 - M), __expf(l2 - M)}; const float inv = 1.0f / (e[0] + e[1] + e[2]);
        float o[8] = {0.f, 0.f, 0.f, 0.f, 0.f, 0.f, 0.f, 0.f};
#pragma unroll
        for (int g = 0; g < 3; ++g) { const u32x4 v = *(const u32x4*)(OG + (size_t)t * ATTW + (4 * g + j) * HD + c8); const float wg = e[g] * inv;
            o[0] += wg * bflo(v.x); o[1] += wg * bfhi(v.x); o[2] += wg * bflo(v.y); o[3] += wg * bfhi(v.y); o[4] += wg * bflo(v.z); o[5] += wg * bfhi(v.z); o[6] += wg * bflo(v.w); o[7] += wg * bfhi(v.w); }
        *(u32x2*)((unsigned char*)AO + (size_t)t * AOW + j * HD + c8) = (u32x2){pk4_fp8(o[0], o[1], o[2], o[3]), pk4_fp8(o[4], o[5], o[6], o[7])};
    }
}
__device__ __forceinline__ void p3_conv(Frame& F) {
    const bf16* P = (const bf16*)(F.ws + WS_PROJ); bf16* CG = (bf16*)(F.ws + WS_CG);
    for (int idx = F.vcu * NTHREADS + F.tid; idx < NT * 128; idx += F.G * NTHREADS) { const int t = idx >> 7, c8 = (idx & 127) * 8, s = t & (SEQ - 1);
        const bf16* pr = P + (size_t)t * INC + c8;
        const u32x4 bv = *(const u32x4*)(pr + COL_B);
        float u[3][8];
#pragma unroll
        for (int d = 0; d < 3; ++d) {
            if (s >= d) { const u32x4 cv = *(const u32x4*)(pr - (size_t)d * INC + COL_C), vv = *(const u32x4*)(pr - (size_t)d * INC + COL_V);
                u[d][0] = bflo(cv.x) * bflo(vv.x); u[d][1] = bfhi(cv.x) * bfhi(vv.x); u[d][2] = bflo(cv.y) * bflo(vv.y); u[d][3] = bfhi(cv.y) * bfhi(vv.y);
                u[d][4] = bflo(cv.z) * bflo(vv.z); u[d][5] = bfhi(cv.z) * bfhi(vv.z); u[d][6] = bflo(cv.w) * bflo(vv.w); u[d][7] = bfhi(cv.w) * bfhi(vv.w); }
            else {
#pragma unroll
                for (int k = 0; k < 8; ++k) u[d][k] = 0.f; } }
        float bb[8] = {bflo(bv.x), bfhi(bv.x), bflo(bv.y), bfhi(bv.y), bflo(bv.z), bfhi(bv.z), bflo(bv.w), bfhi(bv.w)};
        float o[8];
#pragma unroll
        for (int k = 0; k < 8; ++k) { const float w2 = F.conv_w[2 * CONVW + c8 + k], w1 = F.conv_w[CONVW + c8 + k], w0 = F.conv_w[c8 + k];
            o[k] = bb[k] * (w2 * u[0][k] + w1 * u[1][k] + w0 * u[2][k]); }
        *(u32x2*)((unsigned char*)CG + (size_t)t * CONVW + c8) = (u32x2){pk4_fp8(o[0], o[1], o[2], o[3]), pk4_fp8(o[4], o[5], o[6], o[7])};
    }
}

__device__ __forceinline__ void p6_route(Frame& F, bool dry) {
    const int gw = F.vcu * NWAVES + F.wave, NGW = F.G * NWAVES, lane = F.lane, w = F.wave, fr = lane & 15, fq = lane >> 4;
    const float* mod = (const float*)(F.ws + WS_MOD); const float* X1 = (const float*)(F.ws + WS_X1); bf16* H2 = (bf16*)(F.ws + WS_H2);
    const bf16* wrh = (const bf16*)(F.ws + WS_WRH); const bf16* wrl = (const bf16*)(F.ws + WS_WRL);
    int* tkid = (int*)(F.ws + WS_TKID); float* tkw = (float*)(F.ws + WS_TKW); int* tkpos = (int*)(F.ws + WS_TKPOS); int* list = (int*)(F.ws + WS_LIST);
    int* cnt = (int*)(F.ws + WS_CTL) + CW_CNT;
    constexpr int HP = 520;
    constexpr int TPW = 2;
    LAS bf16* Hh = (LAS bf16*)(F.lds); LAS bf16* Hl = Hh + 16 * HP;
    LAS float* lg = (LAS float*)(F.lds + 2 * 16 * HP * 2);
    LAS int* hist = (LAS int*)(F.lds + 2 * 16 * HP * 2 + 2 * 16 * 64 * 4); LAS int* basep = hist + 64;
    const float rbias = F.router_bias[lane];
    for (int t0 = gw; t0 < NT; t0 += TPW * NGW) {
        if (F.tid < 64) hist[F.tid] = 0;
        f32x4 yv[TPW][8];
#pragma unroll
        for (int k = 0; k < TPW; ++k) { const int t = t0 + k * NGW; const int tc = t < NT ? t : NT - 1; const f32x4* xr = (const f32x4*)(X1 + (size_t)tc * D) + lane;
#pragma unroll
            for (int j = 0; j < 8; ++j) yv[k][j] = __builtin_nontemporal_load(xr + 64 * j); }
        f32x4 ma[8], mb[8];
        const int b0 = __builtin_amdgcn_readfirstlane(((t0 < NT) ? t0 : NT - 1) / SEQ);
#pragma unroll
        for (int j = 0; j < 8; ++j) { const int col = 4 * lane + 256 * j;
            const f32x4 g = *(const f32x4*)(F.norm_ffn_g + col), sc = *(const f32x4*)(mod + b0 * 6 * D + 4 * D + col); mb[j] = *(const f32x4*)(mod + b0 * 6 * D + 3 * D + col); ma[j] = g * (sc + 1.0f); }
#pragma unroll
        for (int k = 0; k < TPW; ++k) { const int t = t0 + k * NGW; const int tc = t < NT ? t : NT - 1; const int b = __builtin_amdgcn_readfirstlane(tc / SEQ);
            float ss = 0.f;
#pragma unroll
            for (int j = 0; j < 8; ++j) ss += (yv[k][j].x * yv[k][j].x + yv[k][j].y * yv[k][j].y) + (yv[k][j].z * yv[k][j].z + yv[k][j].w * yv[k][j].w);
            const float rstd = rsqrtf(wave_sum(ss) * (1.f / D) + EPS);
            unsigned* o = (unsigned*)((unsigned char*)H2 + (size_t)tc * D) + lane;
#pragma unroll
            for (int j = 0; j < 8; ++j) { f32x4 a = ma[j], bb = mb[j];
                if (b != b0) { const int col = 4 * lane + 256 * j;
                    const f32x4 g = *(const f32x4*)(F.norm_ffn_g + col), sc = *(const f32x4*)(mod + b * 6 * D + 4 * D + col); bb = *(const f32x4*)(mod + b * 6 * D + 3 * D + col); a = g * (sc + 1.0f); }
                yv[k][j] = yv[k][j] * rstd * a + bb;
                if (t < NT) o[64 * j] = pk4_fp8(yv[k][j].x, yv[k][j].y, yv[k][j].z, yv[k][j].w); } }
        f32x4 acc = {0.f, 0.f, 0.f, 0.f};
        const int wu = __builtin_amdgcn_readfirstlane(w), ni = wu & 3, kh = wu >> 2;
        const bf16x8* bh = (const bf16x8*)(wrh + (size_t)(ni * 64 + 8 * kh) * 512) + lane; const bf16x8* bl = (const bf16x8*)(wrl + (size_t)(ni * 64 + 8 * kh) * 512) + lane;
        bf16x8 wh[8], wl[8];
#pragma unroll
        for (int q = 0; q < 8; ++q) { wh[q] = bh[64 * q]; wl[q] = bl[64 * q]; }
#pragma unroll
        for (int c = 0; c < 4; ++c) {
            __syncthreads();
#pragma unroll
            for (int k = 0; k < TPW; ++k)
#pragma unroll
                for (int jj = 0; jj < 2; ++jj) { const f32x4 y = yv[k][2 * c + jj];
                    const unsigned h0 = f2bf(y.x), h1 = f2bf(y.y), h2_ = f2bf(y.z), h3 = f2bf(y.w);
                    const int off = (8 * k + w) * HP + 4 * lane + 256 * jj;
                    *(LAS u32x2*)(Hh + off) = (u32x2){h0 | (h1 << 16), h2_ | (h3 << 16)};
                    *(LAS u32x2*)(Hl + off) = (u32x2){pk2(y.x - __builtin_bit_cast(float, h0 << 16), y.y - __builtin_bit_cast(float, h1 << 16)), pk2(y.z - __builtin_bit_cast(float, h2_ << 16), y.w - __builtin_bit_cast(float, h3 << 16))}; }
            __syncthreads();
            {
#pragma unroll
                for (int q = 0; q < 8; ++q) { const int ks = 8 * kh + q;
                    const bf16x8 ah = *(const LAS bf16x8*)(Hh + fr * HP + 32 * ks + 8 * fq), al = *(const LAS bf16x8*)(Hl + fr * HP + 32 * ks + 8 * fq);
                    acc = __builtin_amdgcn_mfma_f32_16x16x32_bf16(ah, wh[q], acc, 0, 0, 0);
                    acc = __builtin_amdgcn_mfma_f32_16x16x32_bf16(ah, wl[q], acc, 0, 0, 0);
                    acc = __builtin_amdgcn_mfma_f32_16x16x32_bf16(al, wh[q], acc, 0, 0, 0); } }
            if (c < 3) {
#pragma unroll
                for (int q = 0; q < 8; ++q) { wh[q] = bh[64 * (16 * (c + 1) + q)]; wl[q] = bl[64 * (16 * (c + 1) + q)]; } }
        }
#pragma unroll
        for (int r = 0; r < 4; ++r) lg[kh * 1024 + (4 * fq + r) * 64 + 16 * ni + fr] = acc[r];
        __syncthreads();
        int loc[TPW], rk[TPW]; bool ch[TPW];
#pragma unroll
        for (int k = 0; k < TPW; ++k) { const int t = t0 + k * NGW; ch[k] = false; loc[k] = 0; rk[k] = 0;
            if (t < NT) {
                const float logit = lg[(8 * k + w) * 64 + lane] + lg[1024 + (8 * k + w) * 64 + lane];
                const float scv = sigmoidf_(logit), sel = scv + rbias;
                int rin = 0;
#pragma unroll
                for (int d = 1; d < 8; ++d) { const float ov = __shfl_xor(sel, d); const int oj = lane ^ d; rin += ((ov > sel) || (ov == sel && oj < lane)) ? 1 : 0; }
                float gs = rin < 2 ? sel : 0.f; gs += __shfl_xor(gs, 1); gs += __shfl_xor(gs, 2); gs += __shfl_xor(gs, 4);
                const int myg = lane >> 3; int grank = 0;
#pragma unroll
                for (int d = 1; d < 8; ++d) { const float ov = __shfl_xor(gs, d << 3); const int og = myg ^ d; grank += ((ov > gs) || (ov == gs && og < myg)) ? 1 : 0; }
                const float mv = (grank < 4) ? sel : -1e30f;
                LAS float* mvt = (LAS float*)(hist + 128) + (w * TPW + k) * 64;
                mvt[lane] = mv; LDS_WAIT(); __builtin_amdgcn_wave_barrier();
                int rank = 0;
#pragma unroll
                for (int d4 = 0; d4 < 16; ++d4) { const f32x4 o4 = *(const LAS f32x4*)(mvt + 4 * d4);
#pragma unroll
                    for (int i = 0; i < 4; ++i) { const int oj = 4 * d4 + i; const float ov = o4[i]; rank += ((ov > mv) || (ov == mv && oj < lane)) ? 1 : 0; } }
                const bool chosen = rank < TOPK;
                const float wsum = wave_sum(chosen ? scv : 0.f);
                ch[k] = chosen && !dry; rk[k] = rank;
                if (ch[k]) { loc[k] = __hip_atomic_fetch_add(hist + lane, 1, __ATOMIC_RELAXED, __HIP_MEMORY_SCOPE_WORKGROUP); tkid[t * 8 + rank] = lane; tkw[t * 8 + rank] = scv / wsum * 2.5f; }
                if (lane == 0 && !dry) list[NE * LISTCAP + t] = t;
            } }
        __syncthreads();
        if (F.tid < 64) { const int c = hist[F.tid]; basep[F.tid] = (c > 0) ? atomicAdd(cnt + F.tid * CNT_STRIDE, c) : 0; }
        __syncthreads();
#pragma unroll
        for (int k = 0; k < TPW; ++k) { const int t = t0 + k * NGW;
            if (ch[k]) { const int pos = basep[lane] + loc[k]; list[lane * LISTCAP + pos] = t; tkpos[t * 8 + rk[k]] = pos; } }
        __syncthreads();
    }
}
__device__ __forceinline__ int moe_tables(Frame& F, LAS int*& tp, LAS int*& cn, LAS int*& of) {
    LAS int* base = (LAS int*)(F.lds + 131072 + 8192);
    cn = base; of = base + 80; tp = base + 160;
    const int* cnt = (const int*)(F.ws + WS_CTL) + CW_CNT;
    if (F.wave == 0) {
        const int lane = F.lane; const int c = __hip_atomic_load(cnt + lane * CNT_STRIDE, __ATOMIC_RELAXED, __HIP_MEMORY_SCOPE_AGENT); const int tl = (c + 255) >> 8;
        int so = c, st = tl;
#pragma unroll
        for (int o = 1; o < 64; o <<= 1) { const int a = __shfl_up(so, o), b2 = __shfl_up(st, o); if (lane >= o) { so += a; st += b2; } }
        cn[lane] = c; of[lane] = so - c; tp[lane] = st - tl;
        if (lane == 63) { cn[NE] = NT; of[NE] = so; tp[NE] = st; tp[NEX] = st + NT / 256; }
    }
    __syncthreads();
    return tp[NEX];
}

__device__ __forceinline__ f32x2 fp8x2_lo(unsigned w) { return __builtin_amdgcn_cvt_pk_f32_fp8((int)w, false); }
__device__ __forceinline__ f32x2 fp8x2_hi(unsigned w) { return __builtin_amdgcn_cvt_pk_f32_fp8((int)w, true); }
__device__ __forceinline__ void p9_final(Frame& F, const LAS int* of) {
    const int gw = F.vcu * NWAVES + F.wave, NGW = F.G * NWAVES, lane = F.lane;
    const float* mod = (const float*)(F.ws + WS_MOD); const float* X1 = (const float*)(F.ws + WS_X1); const unsigned char* Y = (const unsigned char*)(F.ws + WS_Y);
    const int* tkid = (const int*)(F.ws + WS_TKID); const float* tkw = (const float*)(F.ws + WS_TKW); const int* tkpos = (const int*)(F.ws + WS_TKPOS);
    for (int t0 = gw; t0 < NT; t0 += 2 * NGW) {
        int rowv[2]; float wv[2]; int tt[2];
#pragma unroll
        for (int k = 0; k < 2; ++k) { const int t = (t0 + k * NGW < NT) ? t0 + k * NGW : t0; tt[k] = t;
            rowv[k] = of[NE] + t; wv[k] = 1.0f;
            if (lane < TOPK) { const int e = tkid[t * 8 + lane]; rowv[k] = of[e] + tkpos[t * 8 + lane]; wv[k] = tkw[t * 8 + lane]; } }
        u32x4 yv[2][9][2];
#pragma unroll
        for (int k = 0; k < 2; ++k)
#pragma unroll
            for (int q = 0; q < 9; ++q) { const int row = __builtin_amdgcn_readlane(rowv[k], q); const u32x4* yr = (const u32x4*)(Y + (size_t)row * D) + lane;
                yv[k][q][0] = __builtin_nontemporal_load(yr); yv[k][q][1] = __builtin_nontemporal_load(yr + 64); }
#pragma unroll
        for (int k = 0; k < 2; ++k) { const int t = tt[k]; const int b = t / SEQ;
            f32x4 m[8];
#pragma unroll
            for (int j = 0; j < 8; ++j) m[j] = (f32x4){0.f, 0.f, 0.f, 0.f};
#pragma unroll
            for (int q = 0; q < 9; ++q) { const float wk = __builtin_bit_cast(float, __builtin_amdgcn_readlane(__builtin_bit_cast(int, wv[k]), q));
#pragma unroll
                for (int j = 0; j < 2; ++j) { const unsigned ww[4] = {yv[k][q][j].x, yv[k][q][j].y, yv[k][q][j].z, yv[k][q][j].w};
#pragma unroll
                    for (int c = 0; c < 4; ++c) { const f32x2 lo = fp8x2_lo(ww[c]), hi = fp8x2_hi(ww[c]); m[4 * j + c] += (f32x4){lo.x, lo.y, hi.x, hi.y} * wk; } } }
            float ss = 0.f;
#pragma unroll
            for (int j = 0; j < 2; ++j)
#pragma unroll
                for (int c = 0; c < 4; ++c) { const int col = 16 * lane + 1024 * j + 4 * c; const f32x4 g2 = *(const f32x4*)(mod + b * 6 * D + 5 * D + col);
                    f32x4& v = m[4 * j + c]; v = *(const f32x4*)(X1 + (size_t)t * D + col) + g2 * v; ss += (v.x * v.x + v.y * v.y) + (v.z * v.z + v.w * v.w); }
            const float rstd = rsqrtf(wave_sum(ss) * (1.f / D) + EPS);
            if (k == 0 || t0 + NGW < NT) {
#pragma unroll
                for (int j = 0; j < 2; ++j)
#pragma unroll
                    for (int c = 0; c < 4; ++c) { const int col = 16 * lane + 1024 * j + 4 * c; *(f32x4*)(F.out + (size_t)t * D + col) = m[4 * j + c] * rstd * *(const f32x4*)(F.norm_final_g + col); } }
        }
    }
}

#define GEMM_PHASE(S, E) gemm_phase<decltype(E), decltype(S), true, false>(F.lds, S, E)
#define GEMM_PHASE8(S, E) gemm_phase<decltype(E), decltype(S), true, true>(F.lds, S, E)
constexpr int N_CONV_CU = 108;
struct Args { const void* in[21]; float* out; unsigned char* ws; int ph_lo, ph_hi; };
constexpr int N_PHASES = 10;

__global__ void __launch_bounds__(NTHREADS, 2) fwd(Args args) {
    extern __shared__ __attribute__((aligned(16))) unsigned char lds[];
    Frame F;
    F.lds = (LAS unsigned char*)lds;
    F.tid = threadIdx.x; F.lane = F.tid & 63; F.wave = __builtin_amdgcn_readfirstlane(F.tid >> 6);
    F.G = gridDim.x; { const int bx = blockIdx.x; F.vcu = (F.G % 8 == 0) ? (bx % 8) * (F.G / 8) + bx / 8 : bx; }
    F.ws = args.ws; F.out = args.out;
    F.x = (const float*)args.in[0]; F.c = (const float*)args.in[1]; F.positions = (const int*)args.in[2]; F.norm_mix_g = (const float*)args.in[3];
    F.w_ada = (const float*)args.in[4]; F.b_ada = (const float*)args.in[5]; F.w_in = (const float*)args.in[6]; F.conv_w = (const float*)args.in[7];
    F.w_conv_out = (const float*)args.in[8]; F.w_attn_out = (const float*)args.in[9]; F.w_o = (const float*)args.in[10]; F.norm_ffn_g = (const float*)args.in[11];
    F.w_router = (const float*)args.in[12]; F.router_bias = (const float*)args.in[13]; F.w_exp_gate = (const float*)args.in[14]; F.w_exp_up = (const float*)args.in[15];
    F.w_exp_down = (const float*)args.in[16]; F.w_sh_gate = (const float*)args.in[17]; F.w_sh_up = (const float*)args.in[18]; F.w_sh_down = (const float*)args.in[19];
    F.norm_final_g = (const float*)args.in[20];
    const int lo = args.ph_lo, hi = args.ph_hi;
#define IN(k) (lo <= (k) && (k) < hi)
#define SEAM(k) do { if (IN(k) && IN((k) + 1)) xcd_barrier(bar); } while (0)
    if (F.tid == 0) { ((LAS unsigned*)(F.lds + LDS_BARW))[0] = 0u; ((LAS unsigned*)(F.lds + LDS_BARW))[1] = 0u; }
    __syncthreads();
    XcdBarrier bar; bar.bar = (unsigned*)(args.ws + WS_CTL) + CW_BAR; bar.x = 0; bar.st = nullptr;
    if (hi - lo > 1) bar = xcd_barrier_post((unsigned*)(args.ws + WS_CTL) + CW_BAR, (volatile LAS unsigned*)(F.lds + LDS_BARW));
    unsigned char* ws = F.ws;
    const float* mod = (const float*)(ws + WS_MOD);

    if (IN(0)) { p0_prologue(F); }
    SEAM(0);
    if (IN(1)) { p1_hnorm(F); }
    SEAM(1);
    if (IN(2)) {
        const int ngemm = (F.G > N_CONV_CU + 8) ? F.G - N_CONV_CU : F.G;
        if ((int)blockIdx.x < ngemm) {
            SchedPlain S; S.init((const bf16*)(ws + WS_H), (const bf16*)(ws + WS_WIN), NT, INC, D / 2, ngemm, (int)blockIdx.x); S.gs = 4;
            EpiProj E{(bf16*)(ws + WS_PROJ), (const f32x2*)(ws + WS_ROPE)};
            GEMM_PHASE8(S, E);
        }
        if (ngemm == F.G || (int)blockIdx.x >= ngemm) {
            const int nconv = (ngemm == F.G) ? F.G : F.G - ngemm, ci = (ngemm == F.G) ? (int)blockIdx.x : (int)blockIdx.x - ngemm;
            constexpr int NS = P0_NSTEPS - P0_S_MIX;
            convert_experts(F, (int)(((long)ci * NS) / nconv), (int)(((long)(ci + 1) * NS) / nconv), F.lds + F.wave * 16384);
        }
    }
    SEAM(2);
    if (IN(3)) { p3_attn(F); p3_conv(F); xcd_barrier(bar); p4_combine(F); }
    SEAM(3);
    if (IN(4)) {
        { SchedPlain S; S.init((const bf16*)(ws + WS_CG), (const bf16*)(ws + WS_WC), NT, D, CONVW / 2, F.G, (int)blockIdx.x);
          EpiGate<false> E{(const bf16*)(ws + WS_PROJ), COL_GC, nullptr, (bf16*)(ws + WS_T1)}; GEMM_PHASE8(S, E); }
        { SchedPlain S; S.init((const bf16*)(ws + WS_AO), (const bf16*)(ws + WS_WA), NT, D, AOW / 2, F.G, (int)blockIdx.x);
          EpiGate<true> E{(const bf16*)(ws + WS_PROJ), COL_GA, (const bf16*)(ws + WS_T1), (bf16*)(ws + WS_MG)}; GEMM_PHASE8(S, E); }
    }
    SEAM(4);
    if (IN(5)) {
        SchedPlain S; S.init((const bf16*)(ws + WS_MG), (const bf16*)(ws + WS_WO), NT, D, D / 2, F.G, (int)blockIdx.x);
        EpiX1 E{F.x, mod + 2 * D, (float*)(ws + WS_X1)}; GEMM_PHASE8(S, E);
    }
    SEAM(5);
    if (IN(6)) { p6_route(F, false); }
    SEAM(6);
    if (IN(7)) {
        LAS int *tp, *cn, *of; const int ntiles = moe_tables(F, tp, cn, of);
        SchedMoE S; S.A = ws + WS_H2; S.Bt = ws + WS_WGU; S.list = (const int*)(ws + WS_LIST); S.KB = D; S.NTN = 4; S.G = F.G; S.c = (int)blockIdx.x;
        S.nwg = ntiles * 4; S.bstride = (size_t)1024 * D; S.gather = true; S.tp = tp; S.cnt = cn; S.off = of;
        {
            LAS int* llw = (LAS int*)(F.lds + 131072); Unit u;
            for (int i = 0; i < 8 && S.next(i, u); ++i) if (F.tid < 256) llw[i * 256 + F.tid] = S.list[u.e * LISTCAP + 256 * u.pm + (F.tid < u.nvalid ? F.tid : u.nvalid - 1)];
            S.ll = llw; __syncthreads(); }
        EpiGU E{(bf16*)(ws + WS_HS)}; GEMM_PHASE8(S, E);
    }
    SEAM(7);
    if (IN(8)) {
        LAS int *tp, *cn, *of; const int ntiles = moe_tables(F, tp, cn, of);
        SchedMoE S; S.A = ws + WS_HS; S.Bt = ws + WS_WD; S.list = nullptr; S.KB = DE; S.NTN = 8; S.G = F.G; S.c = (int)blockIdx.x;
        S.nwg = ntiles * 8; S.bstride = (size_t)D * DE; S.gather = false; S.ll = nullptr; S.tp = tp; S.cnt = cn; S.off = of;
        EpiDown E{(bf16*)(ws + WS_Y)}; GEMM_PHASE8(S, E);
    }
    SEAM(8);
    if (IN(9)) { LAS int *tp, *cn, *of; (void)moe_tables(F, tp, cn, of); p9_final(F, of); }
#undef IN
#undef SEAM
}

extern "C" void kernel_launch(void* const* d_in, const int* in_sizes, int n_in, void* d_out, int out_size, void* d_ws, size_t ws_size, hipStream_t stream) {
    static int grid = 0;
    if (grid == 0) {
        if (n_in != 21 || out_size != NT * D || ws_size < WS_END) { fprintf(stderr, "kernel_launch: unexpected shapes (n_in %d out %d ws %zu)\n", n_in, out_size, ws_size); grid = -1; return; }
        int dev = 0, cus = 0;
        if (hipGetDevice(&dev) != hipSuccess || hipDeviceGetAttribute(&cus, hipDeviceAttributeMultiprocessorCount, dev) != hipSuccess) { grid = -1; return; }
        if (hipFuncSetAttribute((const void*)fwd, hipFuncAttributeMaxDynamicSharedMemorySize, LDS_BYTES) != hipSuccess) { fprintf(stderr, "kernel_launch: hipFuncSetAttribute failed\n"); grid = -1; return; }
        (void)hipGetLastError();
        grid = cus;
    }
    if (grid < 0) return;
    (void)hipMemsetAsync((char*)d_ws + WS_CTL, 0, CTL_ZERO_BYTES, stream);
    Args a{};
    for (int i = 0; i < 21; ++i) a.in[i] = d_in[i];
    a.out = (float*)d_out; a.ws = (unsigned char*)d_ws;
#if defined(MK_PER_PHASE)
    for (int ph = 0; ph < N_PHASES; ++ph) { a.ph_lo = ph; a.ph_hi = ph + 1; hipLaunchKernelGGL(fwd, dim3(grid), dim3(NTHREADS), LDS_BYTES, stream, a); }
#else
    a.ph_lo = 0; a.ph_hi = N_PHASES; hipLaunchKernelGGL(fwd, dim3(grid), dim3(NTHREADS), LDS_BYTES, stream, a);
#endif
}
```
